# Optimizing an MI355X kernel written in HIP

```python
import math
import jax
import jax.numpy as jnp
from jax import lax
import numpy as np

D_MODEL = 1024
BATCH = 8
SEQ = 4096
DEPTH = 2
DEC_BATCH = 8
DEC_SEQ = 16
PAST_LEN = 1024

CHUNK = 64
N_A_LAYERS = DEPTH // 2
N_B_LAYERS = DEPTH - N_A_LAYERS
D_RNN = ((4 * D_MODEL // 3 + 127) // 128) * 128
N_RNN_BLOCKS = 16
RNN_BLOCK = D_RNN // N_RNN_BLOCKS
CONV_W = 4
LRU_C = 8.0
HEAD_DIM = 64
N_HEADS = D_MODEL // (2 * HEAD_DIM)
V_DIM = 2 * HEAD_DIM
ATTN_W = N_HEADS * V_DIM
Q_BLOCK = 128
ROPE_THETA = 10000.0
EPS = 1e-6

kernel_name = 'hawk_yoco_diff_attn_stream'


def _rmsnorm(x, g):
    xf = x.astype(jnp.float32)
    y = xf * lax.rsqrt(jnp.mean(xf * xf, axis=-1, keepdims=True) + EPS)
    return (y * g.astype(jnp.float32)).astype(x.dtype)


def _rope(x, pos):
    half = HEAD_DIM // 2
    inv = ROPE_THETA ** (-jnp.arange(half, dtype=jnp.float32) / half)
    ang = pos.astype(jnp.float32)[:, None] * inv[None, :]
    shape = (1, pos.shape[0]) + (1,) * (x.ndim - 3) + (half,)
    cos = jnp.cos(ang).reshape(shape)
    sin = jnp.sin(ang).reshape(shape)
    xf = x.astype(jnp.float32)
    x1, x2 = xf[..., :half], xf[..., half:]
    return jnp.concatenate([x1 * cos - x2 * sin, x2 * cos + x1 * sin], axis=-1).astype(x.dtype)


def _causal_conv(u, buf, w, b):
    t = u.shape[1]
    up = jnp.concatenate([buf.astype(u.dtype), u], axis=1)
    out = b + up[:, 0:t] * w[0]
    for j in range(1, CONV_W):
        out = out + up[:, j:j + t] * w[j]
    return out, up[:, t:]


def _block_diag(u, w, b):
    bsz, t, _ = u.shape
    ub = u.reshape(bsz, t, N_RNN_BLOCKS, RNN_BLOCK)
    return jnp.einsum('btni,nij->btnj', ub, w).reshape(bsz, t, D_RNN) + b


def _lin_comb(left, right):
    a1, b1 = left
    a2, b2 = right
    return a1 * a2, a2 * b1 + b2


def _rg_lru(u, h0, wr, br, wi, bi, lam):
    uf = u.astype(jnp.float32)
    r = jax.nn.sigmoid(_block_diag(u, wr, br).astype(jnp.float32))
    i = jax.nn.sigmoid(_block_diag(u, wi, bi).astype(jnp.float32))
    log_a = -LRU_C * r * jax.nn.softplus(-lam.astype(jnp.float32))
    a = jnp.exp(log_a)
    mult = jnp.sqrt(-jnp.expm1(2.0 * log_a))
    if h0 is None:
        mult = mult.at[:, 0].set(1.0)
        b = mult * (i * uf)
    else:
        b = mult * (i * uf)
        b = b.at[:, 0].add(a[:, 0] * h0.astype(jnp.float32))
    _, h = lax.associative_scan(_lin_comb, (a, b), axis=1)
    return h.astype(u.dtype), h[:, -1].astype(u.dtype)


def _a_layer(x, conv_buf, h0, norm_g, w_in, conv_w, conv_b, wr, br, wi, bi, lam, w_out):
    h = _rmsnorm(x, norm_g) @ w_in
    u, gate = h[..., :D_RNN], h[..., D_RNN:]
    u, new_buf = _causal_conv(u, conv_buf, conv_w, conv_b)
    y, h_last = _rg_lru(u, h0, wr, br, wi, bi, lam)
    return x + (y * jax.nn.silu(gate)) @ w_out, new_buf, h_last


def _shared_kv(x, pos, kv_norm, kv_w, k_norm):
    bsz, t, _ = x.shape
    kv = _rmsnorm(x, kv_norm) @ kv_w
    k = kv[..., :ATTN_W].reshape(bsz, t, N_HEADS, 2, HEAD_DIM)
    v = kv[..., ATTN_W:].reshape(bsz, t, N_HEADS, V_DIM)
    k = _rope(_rmsnorm(k, k_norm), pos).reshape(bsz, t, N_HEADS, V_DIM)
    return k, v


def _diff_attn(q, k, v, lam, mask):
    bsz, nk = k.shape[:2]
    k = k.reshape(bsz, nk, N_HEADS, 2, HEAD_DIM)
    s = jnp.einsum('bqhcd,bkhcd->bchqk', q, k).astype(jnp.float32) * (HEAD_DIM ** -0.5)
    if mask is not None:
        s = jnp.where(mask, s, -jnp.inf)
    p = jax.nn.softmax(s, axis=-1)
    pd = p[:, 0] - lam * p[:, 1]
    return jnp.einsum('bhqk,bkhe->bqhe', pd.astype(v.dtype), v)


def _prompt_attn(q, k, v, lam):
    bsz, t = q.shape[:2]
    nb = t // Q_BLOCK
    qb = q.reshape(bsz, nb, Q_BLOCK, N_HEADS, 2, HEAD_DIM).swapaxes(0, 1)
    kchunk = jnp.arange(t) // CHUNK

    def one(args):
        qblk, start = args
        qchunk = (start + jnp.arange(Q_BLOCK)) // CHUNK
        mask = kchunk[None, :] <= qchunk[:, None]
        return _diff_attn(qblk, k, v, lam, mask)

    o = lax.map(one, (qb, jnp.arange(nb) * Q_BLOCK))
    return o.swapaxes(0, 1).reshape(bsz, t, N_HEADS, V_DIM)


def _b_layer(x, pos, k, v, norm_g, w_in, q_norm, lq1, lk1, lq2, lk2, head_g, w_out, lam_init, prompt):
    bsz, t, _ = x.shape
    h = _rmsnorm(x, norm_g) @ w_in
    q, gate = h[..., :ATTN_W], h[..., ATTN_W:]
    q = _rope(_rmsnorm(q.reshape(bsz, t, N_HEADS, 2, HEAD_DIM), q_norm), pos)
    lam = (jnp.exp(jnp.sum(lq1.astype(jnp.float32) * lk1.astype(jnp.float32)))
           - jnp.exp(jnp.sum(lq2.astype(jnp.float32) * lk2.astype(jnp.float32))) + lam_init)
    if prompt:
        o = _prompt_attn(q, k, v, lam)
    else:
        o = _diff_attn(q, k, v, lam, None)
    o = _rmsnorm(o, head_g) * (1.0 - lam_init)
    o = o.reshape(bsz, t, ATTN_W) * jax.nn.silu(gate)
    return x + o @ w_out


def _run_group(x, pos, conv_bufs, h0s, past_k, past_v, p):
    prompt = past_k is None
    bsz = x.shape[0]
    new_bufs, new_hs = [], []
    k_new, v_new, k_all, v_all = None, None, None, None
    for i in range(DEPTH):
        if i < N_A_LAYERS:
            if prompt:
                buf = jnp.zeros((bsz, CONV_W - 1, D_RNN), x.dtype)
                h0 = None
            else:
                buf = conv_bufs[i]
                h0 = h0s[i]
            x, nb, nh = _a_layer(x, buf, h0, p['a_norm'][i], p['a_w_in'][i], p['a_conv_w'][i],
                                 p['a_conv_b'][i], p['a_gate_r_w'][i], p['a_gate_r_b'][i],
                                 p['a_gate_i_w'][i], p['a_gate_i_b'][i], p['a_lambda'][i],
                                 p['a_w_out'][i])
            new_bufs.append(nb)
            new_hs.append(nh)
        else:
            if i == N_A_LAYERS:
                k_new, v_new = _shared_kv(x, pos, p['kv_norm'], p['kv_w'], p['k_norm'])
                if prompt:
                    k_all, v_all = k_new, v_new
                else:
                    k_all = jnp.concatenate([past_k.astype(k_new.dtype), k_new], axis=1)
                    v_all = jnp.concatenate([past_v.astype(v_new.dtype), v_new], axis=1)
            j = i - N_A_LAYERS
            lam_init = 0.8 - 0.6 * math.exp(-0.3 * i)
            x = _b_layer(x, pos, k_all, v_all, p['b_norm'][j], p['b_w_in'][j], p['b_q_norm'][j],
                         p['b_lambda_q1'][j], p['b_lambda_k1'][j], p['b_lambda_q2'][j],
                         p['b_lambda_k2'][j], p['b_head_norm'][j], p['b_w_out'][j], lam_init, prompt)
    return x, jnp.stack(new_bufs), jnp.stack(new_hs), k_new, v_new


def _normal(k, shape, scale):
    return jax.random.normal(k, shape, jnp.float32) * scale


def setup_inputs(seed: int = 0) -> dict:
    key = jax.random.key(seed)
    ks = jax.random.split(key, 32)
    na, nbl = N_A_LAYERS, N_B_LAYERS
    u = jax.random.uniform(ks[14], (na, D_RNN), jnp.float32, minval=0.9, maxval=0.999)
    a0 = u ** (1.0 / LRU_C)
    a_lambda = jnp.log(a0) - jnp.log1p(-a0)
    return {
        'x_prompt': _normal(ks[0], (BATCH, SEQ, D_MODEL), 1.0),
        'x_sample': _normal(ks[1], (DEC_BATCH, DEC_SEQ, D_MODEL), 1.0),
        'state_conv': _normal(ks[2], (na, DEC_BATCH, CONV_W - 1, D_RNN), 1.0),
        'state_h': _normal(ks[3], (na, DEC_BATCH, D_RNN), 0.5),
        'cache_k': _normal(ks[4], (DEC_BATCH, PAST_LEN, N_HEADS, V_DIM), 1.0),
        'cache_v': _normal(ks[5], (DEC_BATCH, PAST_LEN, N_HEADS, V_DIM), 1.0),
        'a_norm': 1.0 + _normal(ks[6], (na, D_MODEL), 0.05),
        'a_w_in': _normal(ks[7], (na, D_MODEL, 2 * D_RNN), D_MODEL ** -0.5),
        'a_conv_w': _normal(ks[8], (na, CONV_W, D_RNN), 0.5),
        'a_conv_b': _normal(ks[9], (na, D_RNN), 0.02),
        'a_gate_r_w': _normal(ks[10], (na, N_RNN_BLOCKS, RNN_BLOCK, RNN_BLOCK), RNN_BLOCK ** -0.5),
        'a_gate_r_b': _normal(ks[11], (na, D_RNN), 0.02),
        'a_gate_i_w': _normal(ks[12], (na, N_RNN_BLOCKS, RNN_BLOCK, RNN_BLOCK), RNN_BLOCK ** -0.5),
        'a_gate_i_b': _normal(ks[13], (na, D_RNN), 0.02),
        'a_lambda': a_lambda,
        'a_w_out': _normal(ks[15], (na, D_RNN, D_MODEL), D_RNN ** -0.5),
        'kv_norm': 1.0 + _normal(ks[16], (D_MODEL,), 0.05),
        'kv_w': _normal(ks[17], (D_MODEL, 2 * ATTN_W), D_MODEL ** -0.5),
        'k_norm': 1.0 + _normal(ks[18], (HEAD_DIM,), 0.05),
        'b_norm': 1.0 + _normal(ks[19], (nbl, D_MODEL), 0.05),
        'b_w_in': _normal(ks[20], (nbl, D_MODEL, 2 * ATTN_W), D_MODEL ** -0.5),
        'b_q_norm': 1.0 + _normal(ks[21], (nbl, HEAD_DIM), 0.05),
        'b_lambda_q1': _normal(ks[22], (nbl, HEAD_DIM), 0.1),
        'b_lambda_k1': _normal(ks[23], (nbl, HEAD_DIM), 0.1),
        'b_lambda_q2': _normal(ks[24], (nbl, HEAD_DIM), 0.1),
        'b_lambda_k2': _normal(ks[25], (nbl, HEAD_DIM), 0.1),
        'b_head_norm': 1.0 + _normal(ks[26], (nbl, V_DIM), 0.05),
        'b_w_out': _normal(ks[27], (nbl, ATTN_W, D_MODEL), ATTN_W ** -0.5),
    }


def reference(x_prompt, x_sample, state_conv, state_h, cache_k, cache_v,
              a_norm, a_w_in, a_conv_w, a_conv_b, a_gate_r_w, a_gate_r_b, a_gate_i_w, a_gate_i_b,
              a_lambda, a_w_out, kv_norm, kv_w, k_norm, b_norm, b_w_in, b_q_norm,
              b_lambda_q1, b_lambda_k1, b_lambda_q2, b_lambda_k2, b_head_norm, b_w_out):
    p = dict(a_norm=a_norm, a_w_in=a_w_in, a_conv_w=a_conv_w, a_conv_b=a_conv_b,
             a_gate_r_w=a_gate_r_w, a_gate_r_b=a_gate_r_b, a_gate_i_w=a_gate_i_w,
             a_gate_i_b=a_gate_i_b, a_lambda=a_lambda, a_w_out=a_w_out, kv_norm=kv_norm,
             kv_w=kv_w, k_norm=k_norm, b_norm=b_norm, b_w_in=b_w_in, b_q_norm=b_q_norm,
             b_lambda_q1=b_lambda_q1, b_lambda_k1=b_lambda_k1, b_lambda_q2=b_lambda_q2,
             b_lambda_k2=b_lambda_k2, b_head_norm=b_head_norm, b_w_out=b_w_out)
    pos_p = jnp.arange(x_prompt.shape[1], dtype=jnp.int32)
    pos_s = cache_k.shape[1] + jnp.arange(x_sample.shape[1], dtype=jnp.int32)
    y_p, conv_p, h_p, k_p, v_p = _run_group(x_prompt, pos_p, None, None, None, None, p)
    y_s, conv_s, h_s, k_s, v_s = _run_group(x_sample, pos_s, state_conv, state_h, cache_k, cache_v, p)
    return (y_p, y_s, conv_p, h_p, k_p, v_p, conv_s, h_s, k_s, v_s)
```

```cpp
#include <hip/hip_runtime.h>
#include <hip/hip_cooperative_groups.h>
#include <cstdio>
#include <cstdint>
namespace cg = cooperative_groups;

typedef unsigned short bf16_t;
typedef short bf16x8 __attribute__((ext_vector_type(8)));
typedef short s16x4 __attribute__((ext_vector_type(4)));
typedef float f32x4 __attribute__((ext_vector_type(4)));
typedef float f32x16 __attribute__((ext_vector_type(16)));
typedef unsigned u32x4 __attribute__((ext_vector_type(4)));
typedef unsigned u32x2 __attribute__((ext_vector_type(2)));
#define DI __device__ __forceinline__
#define MFMA32(a, b, c) __builtin_amdgcn_mfma_f32_32x32x16_bf16((a), (b), (c), 0, 0, 0)
#define MFMA16(a, b, c) __builtin_amdgcn_mfma_f32_16x16x32_bf16((a), (b), (c), 0, 0, 0)

constexpr int DM = 1024, SEQ = 4096, DRNN = 1408, RB = 88, PAST = 1024;
constexpr int MP = 32768, MS = 128, MT = MP + MS;
constexpr int KS_LD = 1088;
constexpr float EPS = 1e-6f;
constexpr float LAM_INIT = 0.35550906759096926f;
constexpr float ONE_M_LAM_INIT = 0.64449093240903074f;
constexpr float QSCALE = 0.125f * 1.4426950408889634f;

constexpr size_t O_YP = 0, O_YS = 33554432, O_CONVP = O_YS + 131072, O_HP = O_CONVP + 33792, O_KP = O_HP + 11264,
                 O_VP = O_KP + 33554432, O_CONVS = O_VP + 33554432, O_HS = O_CONVS + 33792, O_KS = O_HS + 11264, O_VS = O_KS + 131072;
constexpr size_t SZ_A1024 = (size_t)MT * 1024 * 2, SZ_A1408 = (size_t)MT * 1408 * 2;
constexpr size_t W_S0 = 0;
constexpr size_t W_S1 = W_S0 + SZ_A1024;
constexpr size_t W_S2 = W_S1 + SZ_A1408;
constexpr size_t W_S3 = W_S2 + SZ_A1408;
constexpr size_t W_S4 = W_S3 + SZ_A1408;
constexpr size_t W_KBS = W_S4 + SZ_A1024;
constexpr size_t W_VTS = W_KBS + (size_t)8 * KS_LD * 1024 * 2;
constexpr size_t W_W1 = W_VTS + (size_t)64 * 128 * KS_LD * 2;
constexpr size_t W_W2 = W_W1 + (size_t)2816 * 1024 * 2;
constexpr size_t W_W3 = W_W2 + (size_t)1024 * 1408 * 2;
constexpr size_t W_W4 = W_W3 + (size_t)4096 * 1024 * 2;
constexpr size_t W_WG = W_W4 + (size_t)1024 * 1024 * 2;
constexpr size_t W_ROPE = W_WG + (size_t)2 * 16 * 96 * 96 * 2;
constexpr size_t W_RSTD0 = W_ROPE + (size_t)4096 * 32 * 8;
constexpr size_t W_SUMSQ = W_RSTD0 + (size_t)MT * 4;
constexpr size_t W_CTR = W_SUMSQ + (size_t)MT * 4;
constexpr size_t W_XCNT = W_CTR + 16384;
constexpr size_t W_END = W_XCNT + 256;

constexpr int LDS_BYTES = 73728;

struct Params {
  const float* in[28];
  float* out;
  unsigned char* ws;
  int ph_lo, ph_hi;
};

DI unsigned pk_bf16(float lo, float hi) { unsigned r; asm("v_cvt_pk_bf16_f32 %0, %1, %2" : "=v"(r) : "v"(lo), "v"(hi)); return r; }
DI bf16x8 pack8_mfma(float a0, float a1, float a2, float a3, float a4, float a5, float a6, float a7) {
  u32x4 p;
  asm("v_cvt_pk_bf16_f32 %0, %4, %5\n\tv_cvt_pk_bf16_f32 %1, %6, %7\n\tv_cvt_pk_bf16_f32 %2, %8, %9\n\tv_cvt_pk_bf16_f32 %3, %10, %11\n\ts_nop 1"
      : "=&v"(p[0]), "=&v"(p[1]), "=&v"(p[2]), "=&v"(p[3]) : "v"(a0), "v"(a1), "v"(a2), "v"(a3), "v"(a4), "v"(a5), "v"(a6), "v"(a7));
  return __builtin_bit_cast(bf16x8, p);
}
DI bf16_t to_bf16(float x) { return (bf16_t)(pk_bf16(x, 0.f) & 0xffffu); }
DI float bf_lo(unsigned u) { return __uint_as_float(u << 16); }
DI float bf_hi(unsigned u) { return __uint_as_float(u & 0xffff0000u); }
DI float bf_to_f(bf16_t x) { return __uint_as_float(((unsigned)x) << 16); }
DI float fast_rcp(float x) { return __builtin_amdgcn_rcpf(x); }
DI float fexp2(float x) { return __builtin_amdgcn_exp2f(x); }
DI float fexp(float x) { return __builtin_amdgcn_exp2f(x * 1.4426950408889634f); }
DI float sigmoidf_(float x) { return fast_rcp(1.f + fexp(-x)); }
DI float siluf_(float x) { return x * sigmoidf_(x); }
DI float neg_expm1(float x) {
  if (x > -0.1f) { return -x * (1.f + x * 0.5f * (1.f + x * (1.f / 3.f) * (1.f + x * 0.25f * (1.f + x * 0.2f)))); }
  return 1.f - fexp(x);
}
DI int crow(int i, int h) { return (i & 3) + 8 * (i >> 2) + 4 * h; }
DI size_t ktidx(int row, int k, int nrows) { return (size_t)(k >> 5) * ((size_t)nrows * 32) + (size_t)row * 32 + (k & 31); }

struct TcJob { const float* src; int ld_src; const float* gain; bf16_t* dst; int ldd; int kt, nt, nrows, row0; };
DI void tconv_load(const TcJob& j, f32x4 (&v)[4]) {
  const int tid = threadIdx.x;
#pragma unroll
  for (int p = 0; p < 4; ++p) {
    const int k = p * 16 + (tid >> 4), n4 = (tid & 15) * 4;
    v[p] = *(const f32x4*)(j.src + (size_t)(j.kt * 64 + k) * j.ld_src + j.nt * 64 + n4);
    if (j.gain) { const float g = j.gain[j.kt * 64 + k]; v[p] = v[p] * g; }
  }
}
DI void tconv_put(const f32x4 (&v)[4], float* tile  ) {
  const int tid = threadIdx.x;
#pragma unroll
  for (int p = 0; p < 4; ++p) { const int k = p * 16 + (tid >> 4), n4 = (tid & 15) * 4; *(f32x4*)(tile + k * 68 + n4) = v[p]; }
}
DI void tconv_store(const TcJob& j, const float* tile) {
  const int tid = threadIdx.x;
#pragma unroll
  for (int p = 0; p < 2; ++p) {
    const int n = tid & 63, kc = (tid >> 6) + 4 * p;
    float x[8];
#pragma unroll
    for (int q = 0; q < 8; ++q) x[q] = tile[(kc * 8 + q) * 68 + n];
    u32x4 w; w[0] = pk_bf16(x[0], x[1]); w[1] = pk_bf16(x[2], x[3]); w[2] = pk_bf16(x[4], x[5]); w[3] = pk_bf16(x[6], x[7]);
    if (j.nrows) *(u32x4*)(j.dst + ktidx(j.row0 + j.nt * 64 + n, j.kt * 64 + kc * 8, j.nrows)) = w;
    else *(u32x4*)(j.dst + (size_t)(j.nt * 64 + n) * j.ldd + j.kt * 64 + kc * 8) = w;
  }
}

DI void prep_phase(const Params& P, unsigned char* lds) {
  const int tid = threadIdx.x, lane = tid & 63, wave = tid >> 6;
  const int G = gridDim.x, bid = blockIdx.x;
  unsigned char* ws = P.ws;
  float* tile = (float*)lds;
  constexpr int T0 = 16 * 44, T1 = T0 + 22 * 16, T2 = T1 + 16 * 32, T3 = T2 + 16 * 32, T4 = T3 + 16 * 16, T5 = T4 + 64 * 32;
  auto mkjob = [&](int u) {
    TcJob j;
    if (u < T0) { j = TcJob{P.in[7], 2816, P.in[6], (bf16_t*)(ws + W_W1), 1024, u / 44, u % 44, 2816, 0}; }
    else if (u < T1) { const int v = u - T0; j = TcJob{P.in[15], 1024, nullptr, (bf16_t*)(ws + W_W2), 1408, v / 16, v % 16, 1024, 0}; }
    else if (u < T2) { const int v = u - T1; j = TcJob{P.in[17], 2048, P.in[16], (bf16_t*)(ws + W_W3), 1024, v / 32, v % 32, 4096, 0}; }
    else if (u < T3) { const int v = u - T2; j = TcJob{P.in[20], 2048, P.in[19], (bf16_t*)(ws + W_W3), 1024, v / 32, v % 32, 4096, 2048}; }
    else if (u < T4) { const int v = u - T3; j = TcJob{P.in[27], 1024, nullptr, (bf16_t*)(ws + W_W4), 1024, v / 16, v % 16, 1024, 0}; }
    else { const int v = u - T4; const int bh = v >> 5, w = v & 31, b = bh >> 3, hd = bh & 7;
      j = TcJob{P.in[5] + (size_t)b * 1024 * 1024 + hd * 128, 1024, nullptr, (bf16_t*)(ws + W_VTS) + (size_t)bh * 128 * KS_LD, KS_LD, w >> 1, w & 1, 0, 0}; }
    return j;
  };
  {
    f32x4 tv[4];
    int u = bid;
    TcJob cur = mkjob(u < T5 ? u : 0);
    if (u < T5) tconv_load(cur, tv);
    while (u < T5) {
      tconv_put(tv, tile);
      __syncthreads();
      const int un = u + G;
      TcJob nxt = mkjob(un < T5 ? un : 0);
      if (un < T5) tconv_load(nxt, tv);
      tconv_store(cur, tile);
      __syncthreads();
      cur = nxt; u = un;
    }
  }
  const int gtid = bid * 256 + tid, gthreads = G * 256;
  for (int idx = gtid; idx < 2 * 16 * 96 * 96; idx += gthreads) {
    const int i = idx % 96, j = (idx / 96) % 96, n = (idx / (96 * 96)) & 15, g = idx / (96 * 96 * 16);
    float v = 0.f;
    if (i < RB && j < RB) v = P.in[g ? 12 : 10][((size_t)n * RB + i) * RB + j];
    ((bf16_t*)(ws + W_WG))[idx] = to_bf16(v);
  }
  for (int idx = gtid; idx < 4096 * 32; idx += gthreads) {
    const int pos = idx >> 5, d = idx & 31;
    const float inv = exp2f(-(float)d * (13.287712379549449f / 32.f));
    const float ang = (float)pos * inv;
    const double a = (double)ang;
    const double nrev = rint(a * 0.15915494309189535);
    const float rr = (float)(a - nrev * 6.283185307179586);
    float2 cs; cs.x = __cosf(rr); cs.y = __sinf(rr);
    ((float2*)(ws + W_ROPE))[idx] = cs;
  }
  for (int idx0 = gtid; idx0 < 8 * 1024 * 256; idx0 += 4 * gthreads) {
    f32x4 v[4];
#pragma unroll
    for (int p = 0; p < 4; ++p) { const int idx = idx0 + p * gthreads; if (idx < 8 * 1024 * 256) v[p] = ((const f32x4*)P.in[4])[idx]; }
#pragma unroll
    for (int p = 0; p < 4; ++p) {
      const int idx = idx0 + p * gthreads;
      if (idx < 8 * 1024 * 256) {
        const int b = idx >> 18, rem = idx & 262143;
        u32x2 w; w.x = pk_bf16(v[p][0], v[p][1]); w.y = pk_bf16(v[p][2], v[p][3]);
        *(u32x2*)((bf16_t*)(ws + W_KBS) + (size_t)b * KS_LD * 1024 + (size_t)rem * 4) = w;
      }
    }
  }
  for (int idx = gtid; idx < 8 * 48 * 512; idx += gthreads) {
    const int b = idx / (48 * 512), rem = idx % (48 * 512);
    ((unsigned*)((bf16_t*)(ws + W_KBS) + (size_t)b * KS_LD * 1024 + (size_t)1040 * 1024))[rem] = 0u;
  }
  for (int idx = gtid; idx < 64 * 128 * 24; idx += gthreads) {
    const int row = idx / 24, c = idx % 24;
    ((unsigned*)((bf16_t*)(ws + W_VTS) + (size_t)row * KS_LD + 1040))[c] = 0u;
  }
  for (int idx = gtid; idx < MT; idx += gthreads) ((float*)(ws + W_SUMSQ))[idx] = 0.f;
  if (gtid < 4096) ((unsigned*)(ws + W_CTR))[gtid] = 0u;
  for (int row0 = (bid * 4 + wave) * 4; row0 < MT; row0 += G * 16) {
    f32x4 v[4][4];
#pragma unroll
    for (int q = 0; q < 4; ++q) {
      const int row = row0 + q;
      const float* src = row < MP ? P.in[0] + (size_t)row * 1024 : P.in[1] + (size_t)(row - MP) * 1024;
#pragma unroll
      for (int i = 0; i < 4; ++i) v[q][i] = *(const f32x4*)(src + i * 256 + lane * 4);
    }
#pragma unroll
    for (int q = 0; q < 4; ++q) {
      const int row = row0 + q;
      bf16_t* dst = (bf16_t*)(ws + W_S0);
      float ss = 0.f;
#pragma unroll
      for (int i = 0; i < 4; ++i) {
        const f32x4 x = v[q][i];
        ss += x[0] * x[0] + x[1] * x[1] + x[2] * x[2] + x[3] * x[3];
        u32x2 w; w.x = pk_bf16(x[0], x[1]); w.y = pk_bf16(x[2], x[3]);
        *(u32x2*)(dst + ktidx(row, i * 256 + lane * 4, MT)) = w;
      }
#pragma unroll
      for (int o = 32; o; o >>= 1) ss += __shfl_xor(ss, o);
      if (lane == 0) ((float*)(ws + W_RSTD0))[row] = rsqrtf(ss * (1.f / 1024.f) + EPS);
    }
  }
}

constexpr int G_ROW = 64, G_A_BYTES = 256 * G_ROW, G_B_BYTES = 128 * G_ROW, G_STAGE = G_A_BYTES + G_B_BYTES;
static_assert(3 * G_STAGE <= LDS_BYTES, "lds");
#define RAW_BARRIER() do { asm volatile("s_waitcnt lgkmcnt(0)" ::: "memory"); __builtin_amdgcn_s_barrier(); } while (0)

template <int K, int NT, bool PIPE, class Epi>
DI void gemm_phase(const bf16_t* __restrict__ A, const bf16_t* __restrict__ Bt,
                   unsigned char* lds, const Epi& epi, const int vx, const int vl, const int nvx) {
  const int tid = threadIdx.x, lane = tid & 63, wave = tid >> 6;
  const int wf = wave & 1, wt = wave >> 1, r = lane & 31, h = lane >> 5;
  const int lrow = tid >> 2, lc = tid & 3;
  const int nk = K >> 5;
  const int mper = 128 / nvx;
  const int ntl = mper * NT + (vx == 0 ? NT : 0);
  const int cmax = (NT - 1) >> 3;
  for (int li = vl; li < ntl; li += 64) {
    int mt, nt;
    int l2 = li;
    bool samp_tile = false;
    if (vx == 0) { if (li < NT) samp_tile = true; else l2 = li - NT; }
    if (samp_tile) { mt = 128; nt = li; }
    else {
      int c = l2 / (mper * 8); c = c > cmax ? cmax : c;
      const int rem = l2 - c * mper * 8, w = (NT - 8 * c) < 8 ? (NT - 8 * c) : 8, mloc = rem / w;
      nt = 8 * c + rem - mloc * w; mt = vx * mper + mloc;
    }
    const bool full = mt < 128;
    const char* Ab = (const char*)(A + (size_t)mt * 256 * 32);
    const char* Bb = (const char*)(Bt + (size_t)nt * 128 * 32);
    const unsigned loff = (unsigned)(lrow * 32 + lc * 8) * 2u;
    constexpr unsigned AKS = (unsigned)MT * 64u, BKS = (unsigned)NT * 128u * 64u;
    f32x16 acc[2][4];
#pragma unroll
    for (int a = 0; a < 2; ++a)
#pragma unroll
      for (int b = 0; b < 4; ++b)
#pragma unroll
        for (int i = 0; i < 16; ++i) acc[a][b][i] = 0.f;
    {
      const unsigned gsrc = (unsigned)((((wave * 16 + (lane >> 2)) * 32) + (((lane & 3) ^ ((lane >> 4) & 3)) * 8)) * 2);
      const int fr = (r >> 2) & 3;
      const int xo0 = ((0 + h) ^ fr) * 16, xo1 = ((2 + h) ^ fr) * 16;
#define G_GL(kt_, st_, NTI) { \
      _Pragma("unroll") for (int p = 0; p < NTI; ++p) __builtin_amdgcn_global_load_lds((const unsigned*)(Ab + (gsrc + (unsigned)(p * 4096) + (unsigned)(kt_) * AKS)), \
          (unsigned*)(lds + (st_) * G_STAGE + (p * 64 + wave * 16) * 64), 16, 0, 0); \
      _Pragma("unroll") for (int p = 0; p < 2; ++p) __builtin_amdgcn_global_load_lds((const unsigned*)(Bb + (gsrc + (unsigned)(p * 4096) + (unsigned)(kt_) * BKS)), \
          (unsigned*)(lds + (st_) * G_STAGE + G_A_BYTES + (p * 64 + wave * 16) * 64), 16, 0, 0); }
#define G_COMP(st_, NTI) { const unsigned char* sA = lds + (st_) * G_STAGE; const unsigned char* sB = sA + G_A_BYTES; \
      bf16x8 W0[2], X0[NTI], W1[2], X1[NTI]; \
      _Pragma("unroll") for (int q = 0; q < 2; ++q) { W0[q] = *(const bf16x8*)(sB + (wf * 64 + q * 32 + r) * 64 + xo0); W1[q] = *(const bf16x8*)(sB + (wf * 64 + q * 32 + r) * 64 + xo1); } \
      _Pragma("unroll") for (int q = 0; q < NTI; ++q) { X0[q] = *(const bf16x8*)(sA + ((2 * q + wt) * 32 + r) * 64 + xo0); X1[q] = *(const bf16x8*)(sA + ((2 * q + wt) * 32 + r) * 64 + xo1); } \
      _Pragma("unroll") for (int ti = 0; ti < NTI; ++ti) _Pragma("unroll") for (int fi = 0; fi < 2; ++fi) acc[fi][ti] = MFMA32(W0[fi], X0[ti], acc[fi][ti]); \
      _Pragma("unroll") for (int ti = 0; ti < NTI; ++ti) _Pragma("unroll") for (int fi = 0; fi < 2; ++fi) acc[fi][ti] = MFMA32(W1[fi], X1[ti], acc[fi][ti]); }
#define G_KLOOP(NTI, WAITN) { \
      G_GL(0, 0, NTI) \
      G_GL(1, 1, NTI) \
      int st = 0, st2 = 2; \
      for (int kt = 0; kt < nk; ++kt) { \
        if (kt + 1 < nk) asm volatile("s_waitcnt vmcnt(" #WAITN ")" ::: "memory"); else asm volatile("s_waitcnt vmcnt(0)" ::: "memory"); \
        RAW_BARRIER(); \
        if (kt + 2 < nk) G_GL(kt + 2, st2, NTI) \
        G_COMP(st, NTI) \
        st = st == 2 ? 0 : st + 1; st2 = st2 == 2 ? 0 : st2 + 1; \
      } }
      if (full) G_KLOOP(4, 6) else G_KLOOP(2, 4)
#undef G_KLOOP
#undef G_COMP
#undef G_GL
    }
    __syncthreads();
    epi(acc, mt, nt, wf, wt, r, h);
    __syncthreads();
  }
}

constexpr int ST_OFF = 0, ST_LD = 68, ST_WAVE = 32 * ST_LD * 4;
static_assert(ST_OFF + 4 * ST_WAVE <= LDS_BYTES, "lds");
#define WAVE_LDS_FENCE() __syncthreads()
DI float* stage_buf(unsigned char* lds) { return (float*)(lds + ST_OFF + (threadIdx.x >> 6) * ST_WAVE); }
DI void stage_put(float* wb, const f32x16& a0, const f32x16& a1, int r, int h) {
#pragma unroll
  for (int g = 0; g < 4; ++g) {
    *(f32x4*)(wb + r * ST_LD + 8 * g + 4 * h) = (f32x4){a0[4 * g], a0[4 * g + 1], a0[4 * g + 2], a0[4 * g + 3]};
    *(f32x4*)(wb + r * ST_LD + 32 + 8 * g + 4 * h) = (f32x4){a1[4 * g], a1[4 * g + 1], a1[4 * g + 2], a1[4 * g + 3]};
  }
}
DI u32x4 pack8(const f32x4& x0, const f32x4& x1) {
  u32x4 w; w[0] = pk_bf16(x0[0], x0[1]); w[1] = pk_bf16(x0[2], x0[3]); w[2] = pk_bf16(x1[0], x1[1]); w[3] = pk_bf16(x1[2], x1[3]); return w;
}

struct Epi1 {
  const float* rstd0; bf16_t* upre; bf16_t* sg; unsigned char* lds;
  DI void operator()(const f32x16 (&acc)[2][4], int mt, int nt, int wf, int wt, int r, int h) const {
    const bool isg = nt >= 11;
    const int lane = threadIdx.x & 63;
    float* wb = stage_buf(lds);
    bf16_t* dst = (isg ? sg : upre) + (isg ? nt - 11 : nt) * 128 + wf * 64;
    const int nti = mt < 128 ? 4 : 2;
#pragma unroll
    for (int ti = 0; ti < 4; ++ti) {
      if (ti < nti) {
        const int base = mt * 256 + (2 * ti + wt) * 32;
        const float rs = rstd0[base + r];
        f32x16 a0, a1;
#pragma unroll
        for (int i = 0; i < 16; ++i) {
          float v0 = acc[0][ti][i] * rs, v1 = acc[1][ti][i] * rs;
          if (isg) { v0 = siluf_(v0); v1 = siluf_(v1); }
          a0[i] = v0; a1[i] = v1;
        }
        stage_put(wb, a0, a1, r, h);
        WAVE_LDS_FENCE();
#pragma unroll
        for (int k = 0; k < 4; ++k) {
          const int row = 8 * k + (lane >> 3), c = (lane & 7) * 8;
          const f32x4 x0 = *(const f32x4*)(wb + row * ST_LD + c), x1 = *(const f32x4*)(wb + row * ST_LD + c + 4);
          *(u32x4*)(dst + (size_t)(base + row) * DRNN + c) = pack8(x0, x1);
        }
        WAVE_LDS_FENCE();
      }
    }
  }
};

struct Epi2 {
  const float* xp; const float* xs; float* yp; float* ys; bf16_t* x1b; float* sumsq; unsigned char* lds;
  DI void operator()(const f32x16 (&acc)[2][4], int mt, int nt, int wf, int wt, int r, int h) const {
    const int lane = threadIdx.x & 63;
    float* wb = stage_buf(lds);
    const int nti = mt < 128 ? 4 : 2;
    const int f0 = nt * 128 + wf * 64;
    const float* xbase = mt < 128 ? xp : xs - (size_t)MP * 1024;
    float* ybase = mt < 128 ? yp : ys - (size_t)MP * 1024;
#pragma unroll
    for (int ti = 0; ti < 4; ++ti) {
      if (ti < nti) {
        const int base = mt * 256 + (2 * ti + wt) * 32;
        stage_put(wb, acc[0][ti], acc[1][ti], r, h);
        WAVE_LDS_FENCE();
        f32x4 xv[8];
#pragma unroll
        for (int k = 0; k < 8; ++k) xv[k] = *(const f32x4*)(xbase + (size_t)(base + 4 * k + (lane >> 4)) * 1024 + f0 + (lane & 15) * 4);
#pragma unroll
        for (int k = 0; k < 8; ++k) {
          const int row = 4 * k + (lane >> 4), c = (lane & 15) * 4;
          const int token = base + row;
          const f32x4 a = *(const f32x4*)(wb + row * ST_LD + c);
          float* yr = ybase + (size_t)token * 1024;
          const f32x4 v = a + xv[k];
          *(f32x4*)(yr + f0 + c) = v;
          u32x2 w; w.x = pk_bf16(v[0], v[1]); w.y = pk_bf16(v[2], v[3]);
          *(u32x2*)(x1b + ktidx(token, f0 + c, MT)) = w;
          float ss = v[0] * v[0] + v[1] * v[1] + v[2] * v[2] + v[3] * v[3];
          ss += __shfl_xor(ss, 1); ss += __shfl_xor(ss, 2); ss += __shfl_xor(ss, 4); ss += __shfl_xor(ss, 8);
          if ((lane & 15) == 0) atomicAdd(sumsq + token, ss);
        }
        WAVE_LDS_FENCE();
      }
    }
  }
};

DI void xchg_store16(bf16_t* p8  , const u32x2& wA, const u32x2& wB, const int h) {
  const u32x2 snd = h ? wA : wB;
  u32x2 rcv; rcv.x = (unsigned)__shfl_xor((int)snd.x, 32); rcv.y = (unsigned)__shfl_xor((int)snd.y, 32);
  const u32x4 o4 = h ? (u32x4){rcv.x, rcv.y, wB.x, wB.y} : (u32x4){wA.x, wA.y, rcv.x, rcv.y};
  *(u32x4*)(p8 + 8 * h) = o4;
}

struct Epi3 {
  const float* sumsq; const float* knorm; const float* qnorm; const float2* rope;
  float* kp; float* vp; float* ks; float* vs;
  bf16_t* kbp; bf16_t* vtp; bf16_t* kbs; bf16_t* vts; bf16_t* qb; bf16_t* sgb;
  DI void operator()(const f32x16 (&acc)[2][4], int mt, int nt, int wf, int wt, int r, int h) const {
    const int sec = nt >> 3, head = nt & 7;
#pragma unroll
    for (int ti = 0; ti < 4; ++ti) {
      const int token = mt * 256 + (2 * ti + wt) * 32 + r;
      if (token >= MT) continue;
      const bool samp = token >= MP;
      const int sidx = token - MP;
      const int b = samp ? (sidx >> 4) : (token >> 12);
      const int t = samp ? (sidx & 15) : (token & 4095);
      const int pos = samp ? PAST + t : t;
      const float rs1 = rsqrtf(sumsq[token] * (1.f / 1024.f) + EPS);
      if (sec == 0 || sec == 2) {
        const float* gn = sec == 0 ? knorm : qnorm;
        float ss = 0.f;
#pragma unroll
        for (int fi = 0; fi < 2; ++fi)
#pragma unroll
          for (int i = 0; i < 16; ++i) { const float v = acc[fi][ti][i] * rs1; ss += v * v; }
        ss += __shfl_xor(ss, 32);
        const float rs = rs1 * rsqrtf(ss * (1.f / 64.f) + EPS);
        const float2* rp = rope + (size_t)pos * 32;
#pragma unroll
        for (int gp = 0; gp < 4; gp += 2) {
          u32x2 w1[2], w2[2];
#pragma unroll
          for (int k2 = 0; k2 < 2; ++k2) {
            const int g = gp + k2;
            const int d0 = 8 * g + 4 * h;
            const f32x4 g1 = *(const f32x4*)(gn + d0), g2 = *(const f32x4*)(gn + 32 + d0);
            const f32x4 cs01 = *(const f32x4*)(rp + d0), cs23 = *(const f32x4*)(rp + d0 + 2);
            const float cc[4] = {cs01[0], cs01[2], cs23[0], cs23[2]}, sn[4] = {cs01[1], cs01[3], cs23[1], cs23[3]};
            f32x4 o1, o2;
#pragma unroll
            for (int q = 0; q < 4; ++q) {
              const float x1 = acc[0][ti][4 * g + q] * rs * g1[q], x2 = acc[1][ti][4 * g + q] * rs * g2[q];
              o1[q] = x1 * cc[q] - x2 * sn[q];
              o2[q] = x2 * cc[q] + x1 * sn[q];
            }
            if (sec == 0) {
              float* ko = samp ? ks + (size_t)sidx * 1024 : kp + (size_t)token * 1024;
              const int col = head * 128 + wf * 64 + d0;
              *(f32x4*)(ko + col) = o1; *(f32x4*)(ko + col + 32) = o2;
              w1[k2].x = pk_bf16(o1[0], o1[1]); w1[k2].y = pk_bf16(o1[2], o1[3]); w2[k2].x = pk_bf16(o2[0], o2[1]); w2[k2].y = pk_bf16(o2[2], o2[3]);
            } else {
              w1[k2].x = pk_bf16(o1[0] * QSCALE, o1[1] * QSCALE); w1[k2].y = pk_bf16(o1[2] * QSCALE, o1[3] * QSCALE);
              w2[k2].x = pk_bf16(o2[0] * QSCALE, o2[1] * QSCALE); w2[k2].y = pk_bf16(o2[2] * QSCALE, o2[3] * QSCALE);
            }
          }
          bf16_t* brow = sec == 0 ? (samp ? kbs + ((size_t)b * KS_LD + PAST + t) * 1024 : kbp + (size_t)token * 1024) : qb + (size_t)token * 1024;
          bf16_t* p8 = brow + head * 128 + wf * 64 + 8 * gp;
          xchg_store16(p8, w1[0], w1[1], h);
          xchg_store16(p8 + 32, w2[0], w2[1], h);
        }
      } else if (sec == 1) {
        float* vo = samp ? vs + (size_t)sidx * 1024 : vp + (size_t)token * 1024;
        bf16_t* vt = samp ? vts + (size_t)(b * 8 + head) * 128 * KS_LD + PAST + t : vtp + (size_t)(b * 8 + head) * 128 * SEQ + t;
        const int vld = samp ? KS_LD : SEQ;
#pragma unroll
        for (int fi = 0; fi < 2; ++fi)
#pragma unroll
          for (int g = 0; g < 4; ++g) {
            const int e0 = wf * 64 + fi * 32 + 8 * g + 4 * h;
            f32x4 v;
#pragma unroll
            for (int q = 0; q < 4; ++q) { v[q] = acc[fi][ti][4 * g + q] * rs1; vt[(size_t)(e0 + q) * vld] = to_bf16(v[q]); }
            *(f32x4*)(vo + head * 128 + e0) = v;
          }
      } else {
        bf16_t* so = sgb + (size_t)token * 1024 + head * 128;
#pragma unroll
        for (int fi = 0; fi < 2; ++fi)
#pragma unroll
          for (int gp = 0; gp < 4; gp += 2) {
            u32x2 w[2];
#pragma unroll
            for (int k2 = 0; k2 < 2; ++k2) {
              const int g = gp + k2;
              w[k2].x = pk_bf16(siluf_(acc[fi][ti][4 * g] * rs1), siluf_(acc[fi][ti][4 * g + 1] * rs1));
              w[k2].y = pk_bf16(siluf_(acc[fi][ti][4 * g + 2] * rs1), siluf_(acc[fi][ti][4 * g + 3] * rs1));
            }
            xchg_store16(so + wf * 64 + fi * 32 + 8 * gp, w[0], w[1], h);
          }
      }
    }
  }
};

struct Epi4 {
  float* yp; float* ys; unsigned char* lds;
  DI void operator()(const f32x16 (&acc)[2][4], int mt, int nt, int wf, int wt, int r, int h) const {
    const int lane = threadIdx.x & 63;
    float* wb = stage_buf(lds);
    const int nti = mt < 128 ? 4 : 2;
    const int f0 = nt * 128 + wf * 64;
#pragma unroll
    for (int ti = 0; ti < 4; ++ti) {
      if (ti < nti) {
        const int base = mt * 256 + (2 * ti + wt) * 32;
        stage_put(wb, acc[0][ti], acc[1][ti], r, h);
        WAVE_LDS_FENCE();
        float* ybase = mt < 128 ? yp : ys - (size_t)MP * 1024;
        f32x4 yv[8];
#pragma unroll
        for (int k = 0; k < 8; ++k) yv[k] = *(const f32x4*)(ybase + (size_t)(base + 4 * k + (lane >> 4)) * 1024 + f0 + (lane & 15) * 4);
#pragma unroll
        for (int k = 0; k < 8; ++k) {
          const int row = 4 * k + (lane >> 4), c = (lane & 15) * 4;
          const f32x4 a = *(const f32x4*)(wb + row * ST_LD + c);
          *(f32x4*)(ybase + (size_t)(base + row) * 1024 + f0 + c) = a + yv[k];
        }
        WAVE_LDS_FENCE();
      }
    }
  }
};

constexpr int R_RAW = 0, R_U = 11808, R_UF = R_U + 64 * 208, R_C = R_UF + 64 * 48 * 4, R_AGG = R_C + 3 * 48 * 4, R_MISC = R_AGG + 2 * 4 * 48 * 4, R_WL = R_MISC + 16;
static_assert(R_WL + 2 * 48 * 208 <= LDS_BYTES, "lds");
template <int N> DI float row_shr(float oldv, float v) {
  return __builtin_bit_cast(float, __builtin_amdgcn_update_dpp(__builtin_bit_cast(int, oldv), __builtin_bit_cast(int, v), 0x110 + N, 0xF, 0xF, false));
}

DI void rec_item(const Params& P, unsigned char* lds, const int item) {
  const int tid = threadIdx.x, lane = tid & 63, wave = tid >> 6;
  const int quad = lane >> 4, tok_l = lane & 15;
  unsigned char* ws = P.ws;
  const bf16_t* upre = (const bf16_t*)(ws + W_S1);
  const bf16_t* sg = (const bf16_t*)(ws + W_S2);
  bf16_t* yg = (bf16_t*)(ws + W_S3);
  const bf16_t* wg = (const bf16_t*)(ws + W_WG);
  unsigned* raw32 = (unsigned*)(lds + R_RAW);
  const bf16_t* raw = (const bf16_t*)(lds + R_RAW);
  unsigned char* Ub = lds + R_U;
  float* Uf = (float*)(lds + R_UF);
  float* Cc = (float*)(lds + R_C);
  float* aggA = (float*)(lds + R_AGG);
  float* aggB = aggA + 4 * 48;
  const bool samp = item >= 256;
  const int it = item & 255, jhalf = it & 1, n = (it >> 1) & 15, b = it >> 5;
  const int T = samp ? 16 : SEQ, nchunks = samp ? 1 : 64;
  const int seqbase = samp ? MP + b * 16 : b * SEQ;
  const int tmax = samp ? 16 : 64;
  const int j0 = jhalf * 48;
  unsigned char* Wl = lds + R_WL;
  for (int idx = tid; idx < 2 * 48 * 12; idx += 256) {
    const int g = idx / 576, rem = idx - g * 576, j = rem / 12, kc = rem - j * 12;
    *(u32x4*)(Wl + (g * 48 + j) * 208 + kc * 16) = *(const u32x4*)(wg + ((size_t)(g * 16 + n) * 96 + j0 + j) * 96 + kc * 8);
  }
  if (tid < 48) {
    const int jj = j0 + tid; const bool valid = jj < RB; const int ch = n * RB + jj;
    Cc[tid] = valid ? P.in[11][ch] : 0.f;
    Cc[48 + tid] = valid ? P.in[13][ch] : 0.f;
    float sp = 0.f;
    if (valid) { const float z = -P.in[14][ch]; sp = z > 15.f ? z : log1pf(__expf(z)); }
    Cc[96 + tid] = -8.f * sp;
  }
  for (int idx = tid; idx < 64 * 8; idx += 256) *(unsigned*)(Ub + (idx >> 3) * 208 + 176 + (idx & 7) * 4) = 0u;
  float hc[3][4];
#pragma unroll
  for (int jt = 0; jt < 3; ++jt)
#pragma unroll
    for (int q = 0; q < 4; ++q) {
      const int jj = j0 + jt * 16 + quad * 4 + q;
      hc[jt][q] = (samp && jj < RB) ? P.in[3][(size_t)b * DRNN + n * RB + jj] : 0.f;
    }
  const int cp = tid % 44, ctg = tid / 44;
  float cw[4][2], cbias[2];
#pragma unroll
  for (int k = 0; k < 4; ++k) { cw[k][0] = 0.f; cw[k][1] = 0.f; }
  cbias[0] = cbias[1] = 0.f;
  if (tid < 176) {
    const int ch = n * RB + 2 * cp;
#pragma unroll
    for (int k = 0; k < 4; ++k) { cw[k][0] = P.in[8][k * DRNN + ch]; cw[k][1] = P.in[8][k * DRNN + ch + 1]; }
    cbias[0] = P.in[9][ch]; cbias[1] = P.in[9][ch + 1];
  }
  u32x4 praw[3]; u32x2 psg[3];
  auto load_chunk = [&](int ci) {
    const int t0 = ci * 64;
#pragma unroll
    for (int p = 0; p < 3; ++p) {
      const int idx = p * 256 + tid;
      u32x4 v = {0u, 0u, 0u, 0u};
      if (idx < 737) {
        const int row = idx / 11, pc = idx - row * 11, trow = t0 - 3 + row;
        if (trow >= 0) {
          if (trow < T) v = *(const u32x4*)(upre + (size_t)(seqbase + trow) * DRNN + n * RB + pc * 8);
        } else if (samp) {
          const float* sp = P.in[2] + ((size_t)b * 3 + (3 + trow)) * DRNN + n * RB + pc * 8;
          const f32x4 a = *(const f32x4*)sp, c = *(const f32x4*)(sp + 4);
          v[0] = pk_bf16(a[0], a[1]); v[1] = pk_bf16(a[2], a[3]); v[2] = pk_bf16(c[0], c[1]); v[3] = pk_bf16(c[2], c[3]);
        }
      }
      praw[p] = v;
      u32x2 sv = {0u, 0u};
      const int tt = t0 + wave * 16 + tok_l, ch0 = j0 + p * 16 + quad * 4;
      if (ch0 < RB && tt < T) sv = *(const u32x2*)(sg + (size_t)(seqbase + tt) * DRNN + n * RB + ch0);
      psg[p] = sv;
    }
  };
  load_chunk(0);
  for (int ci = 0; ci < nchunks; ++ci) {
    u32x2 sgc[3];
#pragma unroll
    for (int p = 0; p < 3; ++p) {
      const int idx = p * 256 + tid;
      if (idx < 737) *(u32x4*)(lds + R_RAW + idx * 16) = praw[p];
      sgc[p] = psg[p];
    }
    __syncthreads();
    if (ci + 1 < nchunks) load_chunk(ci + 1);
    if (tid < 176) {
      const int tb = ctg * 16;
      unsigned x0 = raw32[(tb + 0) * 44 + cp], x1 = raw32[(tb + 1) * 44 + cp], x2 = raw32[(tb + 2) * 44 + cp];
      const int cl = 2 * cp - j0;
      const bool mine = cl >= 0 && cl < 48;
#pragma unroll
      for (int t = 0; t < 16; ++t) {
        const unsigned x3 = raw32[(tb + t + 3) * 44 + cp];
        const float u0 = cbias[0] + cw[0][0] * bf_lo(x0) + cw[1][0] * bf_lo(x1) + cw[2][0] * bf_lo(x2) + cw[3][0] * bf_lo(x3);
        const float u1 = cbias[1] + cw[0][1] * bf_hi(x0) + cw[1][1] * bf_hi(x1) + cw[2][1] * bf_hi(x2) + cw[3][1] * bf_hi(x3);
        *(unsigned*)(Ub + (tb + t) * 208 + cp * 4) = pk_bf16(u0, u1);
        if (mine) { float2 uu; uu.x = u0; uu.y = u1; *(float2*)(Uf + (tb + t) * 48 + cl) = uu; }
        x0 = x1; x1 = x2; x2 = x3;
      }
    }
    if (ci == nchunks - 1 && jhalf == 0) {
      float* co = P.out + (samp ? O_CONVS : O_CONVP) + (size_t)b * 3 * DRNN + n * RB;
      for (int idx = tid; idx < 3 * RB; idx += 256) { const int jr = idx / RB, c = idx - jr * RB; co[(size_t)jr * DRNN + c] = bf_to_f(raw[(tmax + jr) * RB + c]); }
    }
    __syncthreads();
    const int tch = wave * 16 + tok_l;
    float av[3][4], bv[3][4];
    {
      bf16x8 uf[3];
#pragma unroll
      for (int ks = 0; ks < 3; ++ks) uf[ks] = *(const bf16x8*)(Ub + tch * 208 + ks * 64 + quad * 16);
      const bool first = (!samp) && ci == 0 && tch == 0;
      const bool tvalid = tch < tmax;
#pragma unroll
      for (int jt = 0; jt < 3; ++jt) {
        f32x4 ar = {0.f, 0.f, 0.f, 0.f}, ai = {0.f, 0.f, 0.f, 0.f};
#pragma unroll
        for (int ks = 0; ks < 3; ++ks) {
          const bf16x8 wrf = *(const bf16x8*)(Wl + (jt * 16 + tok_l) * 208 + ks * 64 + quad * 16);
          const bf16x8 wif = *(const bf16x8*)(Wl + (48 + jt * 16 + tok_l) * 208 + ks * 64 + quad * 16);
          ar = MFMA16(wrf, uf[ks], ar); ai = MFMA16(wif, uf[ks], ai);
        }
        const f32x4 cbr = *(const f32x4*)(Cc + jt * 16 + quad * 4), cbi = *(const f32x4*)(Cc + 48 + jt * 16 + quad * 4);
        const f32x4 ccs = *(const f32x4*)(Cc + 96 + jt * 16 + quad * 4), uu = *(const f32x4*)(Uf + tch * 48 + jt * 16 + quad * 4);
#pragma unroll
        for (int q = 0; q < 4; ++q) {
          const float rr = sigmoidf_(ar[q] + cbr[q]);
          const float ii = sigmoidf_(ai[q] + cbi[q]);
          const float la = ccs[q] * rr;
          const float a = fexp(la);
          const float x2 = 2.f * la;
          const float e2 = x2 > -0.1f ? -x2 * (1.f + x2 * (0.5f + x2 * ((1.f / 6.f) + x2 * (1.f / 24.f)))) : 1.f - a * a;
          float mult = __builtin_amdgcn_sqrtf(e2);
          if (first) mult = 1.f;
          av[jt][q] = tvalid ? a : 1.f;
          bv[jt][q] = tvalid ? mult * ii * uu[q] : 0.f;
        }
      }
    }
#define SCAN_STEP(N) { const float ap = row_shr<N>(1.f, a), bp = row_shr<N>(0.f, bb); bb = fmaf(a, bp, bb); a = a * ap; }
#pragma unroll
    for (int jt = 0; jt < 3; ++jt) {
#pragma unroll
      for (int q = 0; q < 4; ++q) {
        float a = av[jt][q], bb = bv[jt][q];
        SCAN_STEP(1) SCAN_STEP(2) SCAN_STEP(4) SCAN_STEP(8)
        av[jt][q] = a; bv[jt][q] = bb;
      }
      if (tok_l == 15) {
        *(f32x4*)(aggA + wave * 48 + jt * 16 + quad * 4) = (f32x4){av[jt][0], av[jt][1], av[jt][2], av[jt][3]};
        *(f32x4*)(aggB + wave * 48 + jt * 16 + quad * 4) = (f32x4){bv[jt][0], bv[jt][1], bv[jt][2], bv[jt][3]};
      }
    }
#undef SCAN_STEP
    __syncthreads();
#pragma unroll
    for (int jt = 0; jt < 3; ++jt) {
      float c[4] = {hc[jt][0], hc[jt][1], hc[jt][2], hc[jt][3]}, cin[4] = {0.f, 0.f, 0.f, 0.f};
#pragma unroll
      for (int w2 = 0; w2 < 4; ++w2) {
        const f32x4 A4 = *(const f32x4*)(aggA + w2 * 48 + jt * 16 + quad * 4), B4 = *(const f32x4*)(aggB + w2 * 48 + jt * 16 + quad * 4);
#pragma unroll
        for (int q = 0; q < 4; ++q) { if (w2 == wave) cin[q] = c[q]; c[q] = fmaf(A4[q], c[q], B4[q]); }
      }
      float hv[4];
#pragma unroll
      for (int q = 0; q < 4; ++q) { hc[jt][q] = c[q]; hv[q] = fmaf(av[jt][q], cin[q], bv[jt][q]); }
      const int ch0 = j0 + jt * 16 + quad * 4;
      if (ch0 < RB && tch < tmax) {
        u32x2 w;
        w.x = pk_bf16(hv[0] * bf_lo(sgc[jt].x), hv[1] * bf_hi(sgc[jt].x));
        w.y = pk_bf16(hv[2] * bf_lo(sgc[jt].y), hv[3] * bf_hi(sgc[jt].y));
        *(u32x2*)(yg + ktidx(seqbase + ci * 64 + tch, n * RB + ch0, MT)) = w;
      }
    }
  }
  if (wave == 0 && tok_l == 0) {
#pragma unroll
    for (int jt = 0; jt < 3; ++jt)
#pragma unroll
      for (int q = 0; q < 4; ++q) {
        const int jj = j0 + jt * 16 + quad * 4 + q;
        if (jj < RB) P.out[(samp ? O_HS : O_HP) + (size_t)b * DRNN + n * RB + jj] = hc[jt][q];
      }
  }
}

DI void rec_phase(const Params& P, unsigned char* lds) {
  const int tid = threadIdx.x;
  unsigned* ctr = (unsigned*)(P.ws + W_CTR);
  volatile int* sh = (volatile int*)(lds + R_MISC);
  if (tid == 0) {
    const unsigned hw = __builtin_amdgcn_s_getreg(0xF804), xcc = __builtin_amdgcn_s_getreg(0xF814);
    const unsigned key = ((xcc & 7u) << 8) | ((hw >> 8) & 0xFFu);
    sh[0] = (int)atomicAdd(ctr + 64 + key, 1u);
  }
  __syncthreads();
  const int rank = sh[0];
  for (int pass = 0; pass < 2; ++pass) {
    const bool longq = (pass == 0) == (rank == 0);
    for (;;) {
      __syncthreads();
      if (tid == 0) sh[1] = (int)atomicAdd(ctr + 16 + (longq ? 0 : 1), 1u);
      __syncthreads();
      const int idx = sh[1];
      if (idx >= 256) break;
      rec_item(P, lds, longq ? idx : 256 + idx);
    }
  }
}

constexpr int AK_ROW = 256, AK_BYTES = 64 * AK_ROW, AV_ROW = 128, AV_BYTES = 128 * AV_ROW, A_STAGE = AK_BYTES + AV_BYTES;
static_assert(2 * A_STAGE + 16 <= LDS_BYTES, "lds");

DI void attn_phase(const Params& P, unsigned char* lds, int rep, const int vx) {
  const int tid = threadIdx.x, lane = tid & 63, wave = tid >> 6;
  const int r = lane & 31, h = lane >> 5;
  const int c = wave & 1, g = wave >> 1;
  unsigned char* ws = P.ws;
  const bf16_t* qb = (const bf16_t*)(ws + W_S3);
  const bf16_t* sgb = (const bf16_t*)(ws + W_S4);
  bf16_t* og = (bf16_t*)(ws + W_S0);
  unsigned* ctr = (unsigned*)(ws + W_CTR) + rep * 8;
  volatile int* s_item = (volatile int*)(lds + 2 * A_STAGE);
  float lam;
  {
    float v1 = P.in[22][lane] * P.in[23][lane], v2 = P.in[24][lane] * P.in[25][lane];
#pragma unroll
    for (int o = 32; o; o >>= 1) { v1 += __shfl_xor(v1, o); v2 += __shfl_xor(v2, o); }
    lam = expf(v1) - expf(v2) + LAM_INIT;
  }
  float kmax;
  {
    float gm = fabsf(P.in[18][lane]);
#pragma unroll
    for (int o = 32; o; o >>= 1) gm = fmaxf(gm, __shfl_xor(gm, o));
    kmax = 8.f * gm * 1.02f;
  }
  int q = vx & 7, tries = 0;
  while (tries < 8) {
    if (tid == 0) *s_item = (int)atomicAdd(ctr + q, 1u);
    __syncthreads();
    const int item = *s_item;
    __syncthreads();
    if (item >= 520) { q = (q + 1) & 7; ++tries; continue; }
    const int b = q;
    const bool samp = item < 8;
    int head, nkt, nkeys, qrow0, nq, kld_rows; const bf16_t* kbase; const bf16_t* vbase; int vld;
    if (samp) {
      head = item; nkt = 17; nkeys = 1040; qrow0 = MP + b * 16; nq = 16;
      kbase = (const bf16_t*)(ws + W_KBS) + (size_t)b * KS_LD * 1024 + head * 128;
      vbase = (const bf16_t*)(ws + W_VTS) + (size_t)(b * 8 + head) * 128 * KS_LD; vld = KS_LD;
    } else {
      const int p = item - 8; head = p >> 6; const int chunk = 63 - (p & 63);
      nkt = chunk + 1; nkeys = nkt * 64; qrow0 = b * SEQ + chunk * 64; nq = 64;
      kbase = (const bf16_t*)(ws + W_S1) + (size_t)b * SEQ * 1024 + head * 128;
      vbase = (const bf16_t*)(ws + W_S2) + (size_t)(b * 8 + head) * 128 * SEQ; vld = SEQ;
    }
    (void)kld_rows;
    const bool active = g * 32 < nq;
    int qtok = qrow0 + g * 32 + r; if (qtok > MT - 1) qtok = MT - 1;
    bf16x8 qf[4];
#pragma unroll
    for (int s = 0; s < 4; ++s) qf[s] = *(const bf16x8*)(qb + (size_t)qtok * 1024 + head * 128 + c * 64 + s * 16 + h * 8);
    f32x16 oacc[4];
#pragma unroll
    for (int et = 0; et < 4; ++et)
#pragma unroll
      for (int i = 0; i < 16; ++i) oacc[et][i] = 0.f;
    float mref = 0.f, lsum = 0.f;
    bool fixed_shift = false;
    if (!samp) {
      float qn = 0.f;
#pragma unroll
      for (int s4 = 0; s4 < 4; ++s4)
#pragma unroll
        for (int j = 0; j < 8; ++j) { const float qv = bf_to_f((bf16_t)qf[s4][j]); qn += qv * qv; }
      qn += __shfl_xor(qn, 32);
      const float bnd = __builtin_amdgcn_sqrtf(qn) * kmax + 0.05f;
      fixed_shift = !__any(bnd > 50.f);
      if (fixed_shift) mref = bnd;
    }
    const int klr = wave * 4 + (lane >> 4);
    const int kperm = (klr & 3) | ((klr & 4) << 1) | ((klr & 8) >> 1);
    const bf16_t* kg = kbase + (size_t)kperm * 1024 + (((lane & 15) ^ klr) * 8);
    const int vlr = wave * 8 + (lane >> 3);
    const bf16_t* vg = vbase + (size_t)vlr * vld + (((lane & 7) ^ ((vlr >> 1) & 7)) * 8);
#define A_GL(kt_, st_) { _Pragma("unroll") for (int p = 0; p < 4; ++p) { \
      __builtin_amdgcn_global_load_lds((const unsigned*)(kg + ((size_t)(kt_) * 64 + p * 16) * 1024), (unsigned*)(lds + (st_) * A_STAGE + (p * 16 + wave * 4) * 256), 16, 0, 0); \
      __builtin_amdgcn_global_load_lds((const unsigned*)(vg + (size_t)p * 32 * vld + (kt_) * 64), (unsigned*)(lds + (st_) * A_STAGE + AK_BYTES + (p * 32 + wave * 8) * 128), 16, 0, 0); } }
    A_GL(0, 0)
    const int kx = r & 15, vx7 = (r >> 1) & 7;
    for (int kt = 0; kt < nkt; ++kt) {
      const int cur = kt & 1;
      asm volatile("s_waitcnt vmcnt(0)" ::: "memory");
      RAW_BARRIER();
      if (kt + 1 < nkt) A_GL(kt + 1, cur ^ 1)
      if (active) {
        const unsigned char* sK = lds + cur * A_STAGE;
        const unsigned char* sV = sK + AK_BYTES;
        f32x16 sacc[2];
        const float nmref = -mref;
#pragma unroll
        for (int ks = 0; ks < 2; ++ks) {
#pragma unroll
          for (int i = 0; i < 16; ++i) sacc[ks][i] = nmref;
#pragma unroll
          for (int s = 0; s < 4; ++s) {
            const bf16x8 kf = *(const bf16x8*)(sK + (ks * 32 + r) * AK_ROW + (((c * 8 + 2 * s + h) ^ kx) * 16));
            sacc[ks] = MFMA32(kf, qf[s], sacc[ks]);
          }
        }
        if (kt * 64 + 64 > nkeys) {
#pragma unroll
          for (int ks = 0; ks < 2; ++ks)
#pragma unroll
            for (int i = 0; i < 16; ++i) if (kt * 64 + ks * 32 + 16 * (i >> 3) + 8 * h + 4 * ((i >> 2) & 1) + (i & 3) >= nkeys) sacc[ks][i] = -INFINITY;
        }
        if (!fixed_shift) {
        float mx = sacc[0][0];
#pragma unroll
        for (int ks = 0; ks < 2; ++ks)
#pragma unroll
          for (int i = 0; i < 16; ++i) mx = fmaxf(mx, sacc[ks][i]);
        mx = fmaxf(mx, __shfl_xor(mx, 32));
        if (__any(fabsf(mx) > 8.f)) {
          const float alpha = fexp2(-mx);
          mref += mx; lsum *= alpha;
#pragma unroll
          for (int et = 0; et < 4; ++et)
#pragma unroll
            for (int i = 0; i < 16; ++i) oacc[et][i] *= alpha;
#pragma unroll
          for (int ks = 0; ks < 2; ++ks)
#pragma unroll
            for (int i = 0; i < 16; ++i) sacc[ks][i] -= mx;
        }
        }
        float psum = 0.f;
#pragma unroll
        for (int ks = 0; ks < 2; ++ks)
#pragma unroll
          for (int i = 0; i < 16; ++i) { const float pv = fexp2(sacc[ks][i]); sacc[ks][i] = pv; psum += pv; }
        lsum += psum;
#pragma unroll
        for (int ks = 0; ks < 2; ++ks)
#pragma unroll
          for (int sp = 0; sp < 2; ++sp) {
            const bf16x8 pf = pack8_mfma(sacc[ks][8 * sp + 0], sacc[ks][8 * sp + 1], sacc[ks][8 * sp + 2], sacc[ks][8 * sp + 3],
                                         sacc[ks][8 * sp + 4], sacc[ks][8 * sp + 5], sacc[ks][8 * sp + 6], sacc[ks][8 * sp + 7]);
#pragma unroll
            for (int et = 0; et < 4; ++et) {
              const bf16x8 vf = *(const bf16x8*)(sV + (et * 32 + r) * AV_ROW + ((((ks * 2 + sp) * 2 + h) ^ vx7) * 16));
              oacc[et] = MFMA32(vf, pf, oacc[et]);
            }
          }
      }
    }
#undef A_GL
    __syncthreads();
    const float ltot = lsum + __shfl_xor(lsum, 32);
    const float inv = active ? fast_rcp(ltot) : 0.f;
    float* xb = (float*)lds + g * 4096;
    if (c == 1 && active) {
      const float sc = inv * lam;
#pragma unroll
      for (int et = 0; et < 4; ++et)
#pragma unroll
        for (int i = 0; i < 16; ++i) xb[(et * 16 + i) * 64 + lane] = oacc[et][i] * sc;
    }
    __syncthreads();
    if (c == 0 && active) {
      float ss = 0.f;
#pragma unroll
      for (int et = 0; et < 4; ++et)
#pragma unroll
        for (int i = 0; i < 16; ++i) { const float o = oacc[et][i] * inv - xb[(et * 16 + i) * 64 + lane]; oacc[et][i] = o; ss += o * o; }
      ss += __shfl_xor(ss, 32);
      const float rs = rsqrtf(ss * (1.f / 128.f) + EPS) * ONE_M_LAM_INIT;
      if (g * 32 + r < nq) {
        const int token = qrow0 + g * 32 + r;
        const bf16_t* sgr = sgb + (size_t)token * 1024 + head * 128;
#pragma unroll
        for (int et = 0; et < 4; ++et) {
          f32x4 hgv[4]; u32x2 svv[4];
#pragma unroll
          for (int gq = 0; gq < 4; ++gq) { const int e0 = et * 32 + 8 * gq + 4 * h; hgv[gq] = *(const f32x4*)(P.in[26] + e0); svv[gq] = *(const u32x2*)(sgr + e0); }
          u32x2 wq[4];
#pragma unroll
          for (int gq = 0; gq < 4; ++gq) {
            wq[gq].x = pk_bf16(oacc[et][4 * gq] * rs * hgv[gq][0] * bf_lo(svv[gq].x), oacc[et][4 * gq + 1] * rs * hgv[gq][1] * bf_hi(svv[gq].x));
            wq[gq].y = pk_bf16(oacc[et][4 * gq + 2] * rs * hgv[gq][2] * bf_lo(svv[gq].y), oacc[et][4 * gq + 3] * rs * hgv[gq][3] * bf_hi(svv[gq].y));
          }
#pragma unroll
          for (int gp = 0; gp < 4; gp += 2) {
            const u32x2 snd = h ? wq[gp] : wq[gp + 1];
            u32x2 rcv; rcv.x = (unsigned)__shfl_xor((int)snd.x, 32); rcv.y = (unsigned)__shfl_xor((int)snd.y, 32);
            const u32x4 o4 = h ? (u32x4){rcv.x, rcv.y, wq[gp + 1].x, wq[gp + 1].y} : (u32x4){wq[gp].x, wq[gp].y, rcv.x, rcv.y};
            *(u32x4*)(og + ktidx(token, head * 128 + et * 32 + 8 * (gp + h), MT)) = o4;
          }
        }
      }
    }
    __syncthreads();
  }
}

DI void grid_bar(unsigned* base, const unsigned k, const unsigned xcc, const unsigned nx, const unsigned nact) {
  asm volatile("s_waitcnt vmcnt(0)" ::: "memory");
  __syncthreads();
  if (threadIdx.x == 0) {
    const unsigned old = __hip_atomic_fetch_add(base + 24 + xcc, 1u, __ATOMIC_RELAXED, __HIP_MEMORY_SCOPE_AGENT);
    if (old + 1 == k * nx) {
      __builtin_amdgcn_fence(__ATOMIC_RELEASE, "agent");
      asm volatile("s_waitcnt vmcnt(0)" ::: "memory");
      __hip_atomic_fetch_add(base + 16, 1u, __ATOMIC_RELAXED, __HIP_MEMORY_SCOPE_AGENT);
    }
    unsigned spins = 0;
    while (__hip_atomic_load(base + 16, __ATOMIC_RELAXED, __HIP_MEMORY_SCOPE_AGENT) < k * nact && spins < (1u << 24)) { __builtin_amdgcn_s_sleep(1); ++spins; }
    __builtin_amdgcn_fence(__ATOMIC_ACQUIRE, "agent");
    asm volatile("s_waitcnt vmcnt(0)" ::: "memory");
  }
  __syncthreads();
}

__global__ void __launch_bounds__(256, 2) hawk_yoco_mega(Params P) {
  extern __shared__ __attribute__((aligned(16))) unsigned char lds[];
  cg::grid_group grid = cg::this_grid();
  unsigned char* ws = P.ws;
  int my_xcc, my_lr;
  {
    volatile int* shr = (volatile int*)(lds + LDS_BYTES - 16);
    if (threadIdx.x == 0) {
      const unsigned xcc = __builtin_amdgcn_s_getreg(0xF814) & 7u;
      shr[0] = (int)xcc; shr[1] = (int)atomicAdd((unsigned*)(ws + W_XCNT) + xcc, 1u);
    }
    __syncthreads();
    my_xcc = shr[0]; my_lr = shr[1];
    __syncthreads();
  }
  int gv = 0;
#define vx ((gv & 511) >> 6)
#define vl (gv & 63)
#define nvx ((int)(gridDim.x >> 6))
#ifndef PROBE_PH
#define PROBE_PH -1
#endif
#define PH_BEGIN(n) if (P.ph_lo <= (n) && (n) < P.ph_hi) { _Pragma("unroll 1") for (int rep = 0; rep < ((n) == PROBE_PH ? 2 : 1); ++rep) { if (rep) grid.sync();
#define PH_END(n) } if ((n) + 1 < P.ph_hi) { if ((n) == 0) grid.sync(); else grid_bar((unsigned*)(ws + W_XCNT), (unsigned)(n), (unsigned)(gv >> 9) & 7u, (unsigned)(gv >> 12) & 1023u, (unsigned)(gv >> 22) & 15u); } }
  PH_BEGIN(0)
    prep_phase(P, lds);
  PH_END(0)
  {
    int pre = 0, mynx = 0, nact = 0;
    for (int x = 0; x < 8; ++x) { const int c = (int)__hip_atomic_load((unsigned*)(ws + W_XCNT) + x, __ATOMIC_RELAXED, __HIP_MEMORY_SCOPE_AGENT); if (x < my_xcc) pre += c; if (x == my_xcc) mynx = c; if (c > 0) ++nact; }
    gv = (pre + my_lr) | (my_xcc << 9) | (mynx << 12) | (nact << 22);
  }
  PH_BEGIN(1)
    Epi1 e{(const float*)(ws + W_RSTD0), (bf16_t*)(ws + W_S1), (bf16_t*)(ws + W_S2), lds};
    gemm_phase<1024, 22, true>((const bf16_t*)(ws + W_S0), (const bf16_t*)(ws + W_W1), lds, e, vx, vl, nvx);
  PH_END(1)
  PH_BEGIN(2)
    rec_phase(P, lds);
  PH_END(2)
  PH_BEGIN(3)
    Epi2 e{P.in[0], P.in[1], P.out + O_YP, P.out + O_YS, (bf16_t*)(ws + W_S0), (float*)(ws + W_SUMSQ), lds};
    gemm_phase<1408, 8, true>((const bf16_t*)(ws + W_S3), (const bf16_t*)(ws + W_W2), lds, e, vx, vl, nvx);
  PH_END(3)
  PH_BEGIN(4)
    Epi3 e{(const float*)(ws + W_SUMSQ), P.in[18], P.in[21], (const float2*)(ws + W_ROPE),
           P.out + O_KP, P.out + O_VP, P.out + O_KS, P.out + O_VS,
           (bf16_t*)(ws + W_S1), (bf16_t*)(ws + W_S2), (bf16_t*)(ws + W_KBS), (bf16_t*)(ws + W_VTS), (bf16_t*)(ws + W_S3), (bf16_t*)(ws + W_S4)};
    gemm_phase<1024, 32, false>((const bf16_t*)(ws + W_S0), (const bf16_t*)(ws + W_W3), lds, e, vx, vl, nvx);
  PH_END(4)
  PH_BEGIN(5)
    attn_phase(P, lds, rep, vx);
  PH_END(5)
  PH_BEGIN(6)
    Epi4 e{P.out + O_YP, P.out + O_YS, lds};
    gemm_phase<1024, 8, true>((const bf16_t*)(ws + W_S0), (const bf16_t*)(ws + W_W4), lds, e, vx, vl, nvx);
  PH_END(6)
}

#undef vx
#undef vl
#undef nvx
extern "C" void kernel_launch(void* const* d_in, const int* in_sizes, int n_in, void* d_out, int out_size, void* d_ws, size_t ws_size,
                              hipStream_t stream) {
  static int grid_blocks = 0;
  if (grid_blocks == 0) {
    if (n_in != 28 || ws_size < W_END) { fprintf(stderr, "kernel_launch: unexpected n_in %d / ws_size %zu (need %zu)\n", n_in, ws_size, (size_t)W_END); grid_blocks = -1; return; }
    int dev = 0, cus = 0, per_cu = 0;
    hipGetDevice(&dev);
    hipDeviceGetAttribute(&cus, hipDeviceAttributeMultiprocessorCount, dev);
    hipFuncSetAttribute((const void*)hawk_yoco_mega, hipFuncAttributeMaxDynamicSharedMemorySize, LDS_BYTES);
    hipOccupancyMaxActiveBlocksPerMultiprocessor(&per_cu, (const void*)hawk_yoco_mega, 256, LDS_BYTES);
    if (per_cu < 1) per_cu = 1;
    if (per_cu > 2) per_cu = 2;
    per_cu = 2;
    grid_blocks = cus * per_cu;
    fprintf(stderr, "kernel_launch: cus %d per_cu %d grid %d\n", cus, per_cu, grid_blocks);
  }
  if (grid_blocks < 0) return;
  Params p{};
  for (int i = 0; i < 28; ++i) p.in[i] = (const float*)d_in[i];
  p.out = (float*)d_out; p.ws = (unsigned char*)d_ws;
  p.ph_lo = 0; p.ph_hi = 7;
  (void)hipMemsetAsync((unsigned char*)d_ws + W_XCNT, 0, 256, stream);
  void* args[] = {&p};
  hipError_t e = hipLaunchCooperativeKernel((const void*)hawk_yoco_mega, dim3(grid_blocks), dim3(256), args, LDS_BYTES, stream);
  if (e != hipSuccess) fprintf(stderr, "cooperative launch failed: %s (grid %d)\n", hipGetErrorString(e), grid_blocks);
}
```

```cpp
#include <hip/hip_runtime.h>
#include <hip/hip_cooperative_groups.h>
#include <cstdio>
#include <cstdint>
namespace cg = cooperative_groups;

typedef unsigned short bf16_t;
typedef short bf16x8 __attribute__((ext_vector_type(8)));
typedef short s16x4 __attribute__((ext_vector_type(4)));
typedef float f32x4 __attribute__((ext_vector_type(4)));
typedef float f32x16 __attribute__((ext_vector_type(16)));
typedef unsigned u32x4 __attribute__((ext_vector_type(4)));
typedef unsigned u32x2 __attribute__((ext_vector_type(2)));
#define DI __device__ __forceinline__
#define MFMA32(a, b, c) __builtin_amdgcn_mfma_f32_32x32x16_bf16((a), (b), (c), 0, 0, 0)
#define MFMA16(a, b, c) __builtin_amdgcn_mfma_f32_16x16x32_bf16((a), (b), (c), 0, 0, 0)

constexpr int DM = 1024, SEQ = 4096, DRNN = 1408, RB = 88, PAST = 1024;
constexpr int MP = 32768, MS = 128, MT = MP + MS;
constexpr int KS_LD = 1088;
constexpr float EPS = 1e-6f;
constexpr float LAM_INIT = 0.35550906759096926f;
constexpr float ONE_M_LAM_INIT = 0.64449093240903074f;
constexpr float QSCALE = 0.125f * 1.4426950408889634f;

constexpr size_t O_YP = 0, O_YS = 33554432, O_CONVP = O_YS + 131072, O_HP = O_CONVP + 33792, O_KP = O_HP + 11264,
                 O_VP = O_KP + 33554432, O_CONVS = O_VP + 33554432, O_HS = O_CONVS + 33792, O_KS = O_HS + 11264, O_VS = O_KS + 131072;
constexpr size_t SZ_A1024 = (size_t)MT * 1024 * 2, SZ_A1408 = (size_t)MT * 1408 * 2;
constexpr size_t W_S0 = 0;
constexpr size_t W_S1 = W_S0 + SZ_A1024;
constexpr size_t W_S2 = W_S1 + SZ_A1408;
constexpr size_t W_S3 = W_S2 + SZ_A1408;
constexpr size_t W_S4 = W_S3 + SZ_A1408;
constexpr size_t W_KBS = W_S4 + SZ_A1024;
constexpr size_t W_VTS = W_KBS + (size_t)8 * KS_LD * 1024 * 2;
constexpr size_t W_W1 = W_VTS + (size_t)64 * 128 * KS_LD * 2;
constexpr size_t W_W2 = W_W1 + (size_t)2816 * 1024 * 2;
constexpr size_t W_W3 = W_W2 + (size_t)1024 * 1408 * 2;
constexpr size_t W_W4 = W_W3 + (size_t)4096 * 1024 * 2;
constexpr size_t W_WG = W_W4 + (size_t)1024 * 1024 * 2;
constexpr size_t W_ROPE = W_WG + (size_t)2 * 16 * 96 * 96 * 2;
constexpr size_t W_RSTD0 = W_ROPE + (size_t)4096 * 32 * 8;
constexpr size_t W_SUMSQ = W_RSTD0 + (size_t)MT * 4;
constexpr size_t W_CTR = W_SUMSQ + (size_t)MT * 4;
constexpr size_t W_XCNT = W_CTR + 16384;
constexpr size_t W_END = W_XCNT + 256;

constexpr int LDS_BYTES = 73728;

struct Params {
  const float* in[28];
  float* out;
  unsigned char* ws;
  int ph_lo, ph_hi;
};

DI unsigned pk_bf16(float lo, float hi) { unsigned r; asm("v_cvt_pk_bf16_f32 %0, %1, %2" : "=v"(r) : "v"(lo), "v"(hi)); return r; }
DI bf16x8 pack8_mfma(float a0, float a1, float a2, float a3, float a4, float a5, float a6, float a7) {
  u32x4 p;
  asm("v_cvt_pk_bf16_f32 %0, %4, %5\n\tv_cvt_pk_bf16_f32 %1, %6, %7\n\tv_cvt_pk_bf16_f32 %2, %8, %9\n\tv_cvt_pk_bf16_f32 %3, %10, %11\n\ts_nop 1"
      : "=&v"(p[0]), "=&v"(p[1]), "=&v"(p[2]), "=&v"(p[3]) : "v"(a0), "v"(a1), "v"(a2), "v"(a3), "v"(a4), "v"(a5), "v"(a6), "v"(a7));
  return __builtin_bit_cast(bf16x8, p);
}
DI bf16_t to_bf16(float x) { return (bf16_t)(pk_bf16(x, 0.f) & 0xffffu); }
DI float bf_lo(unsigned u) { return __uint_as_float(u << 16); }
DI float bf_hi(unsigned u) { return __uint_as_float(u & 0xffff0000u); }
DI float bf_to_f(bf16_t x) { return __uint_as_float(((unsigned)x) << 16); }
DI float fast_rcp(float x) { return __builtin_amdgcn_rcpf(x); }
DI float fexp2(float x) { return __builtin_amdgcn_exp2f(x); }
DI float fexp(float x) { return __builtin_amdgcn_exp2f(x * 1.4426950408889634f); }
DI float sigmoidf_(float x) { return fast_rcp(1.f + fexp(-x)); }
DI float siluf_(float x) { return x * sigmoidf_(x); }
DI float neg_expm1(float x) {
  if (x > -0.1f) { return -x * (1.f + x * 0.5f * (1.f + x * (1.f / 3.f) * (1.f + x * 0.25f * (1.f + x * 0.2f)))); }
  return 1.f - fexp(x);
}
DI int crow(int i, int h) { return (i & 3) + 8 * (i >> 2) + 4 * h; }
DI size_t ktidx(int row, int k, int nrows) { return (size_t)(k >> 5) * ((size_t)nrows * 32) + (size_t)row * 32 + (k & 31); }

struct TcJob { const float* src; int ld_src; const float* gain; bf16_t* dst; int ldd; int kt, nt, nrows, row0; };
DI void tconv_load(const TcJob& j, f32x4 (&v)[4]) {
  const int tid = threadIdx.x;
#pragma unroll
  for (int p = 0; p < 4; ++p) {
    const int k = p * 16 + (tid >> 4), n4 = (tid & 15) * 4;
    v[p] = *(const f32x4*)(j.src + (size_t)(j.kt * 64 + k) * j.ld_src + j.nt * 64 + n4);
    if (j.gain) { const float g = j.gain[j.kt * 64 + k]; v[p] = v[p] * g; }
  }
}
DI void tconv_put(const f32x4 (&v)[4], float* tile  ) {
  const int tid = threadIdx.x;
#pragma unroll
  for (int p = 0; p < 4; ++p) { const int k = p * 16 + (tid >> 4), n4 = (tid & 15) * 4; *(f32x4*)(tile + k * 68 + n4) = v[p]; }
}
DI void tconv_store(const TcJob& j, const float* tile) {
  const int tid = threadIdx.x;
#pragma unroll
  for (int p = 0; p < 2; ++p) {
    const int n = tid & 63, kc = (tid >> 6) + 4 * p;
    float x[8];
#pragma unroll
    for (int q = 0; q < 8; ++q) x[q] = tile[(kc * 8 + q) * 68 + n];
    u32x4 w; w[0] = pk_bf16(x[0], x[1]); w[1] = pk_bf16(x[2], x[3]); w[2] = pk_bf16(x[4], x[5]); w[3] = pk_bf16(x[6], x[7]);
    if (j.nrows) *(u32x4*)(j.dst + ktidx(j.row0 + j.nt * 64 + n, j.kt * 64 + kc * 8, j.nrows)) = w;
    else *(u32x4*)(j.dst + (size_t)(j.nt * 64 + n) * j.ldd + j.kt * 64 + kc * 8) = w;
  }
}

DI void prep_phase(const Params& P, unsigned char* lds) {
  const int tid = threadIdx.x, lane = tid & 63, wave = tid >> 6;
  const int G = gridDim.x, bid = blockIdx.x;
  unsigned char* ws = P.ws;
  float* tile = (float*)lds;
  constexpr int T0 = 16 * 44, T1 = T0 + 22 * 16, T2 = T1 + 16 * 32, T3 = T2 + 16 * 32, T4 = T3 + 16 * 16, T5 = T4 + 64 * 32;
  auto mkjob = [&](int u) {
    TcJob j;
    if (u < T0) { j = TcJob{P.in[7], 2816, P.in[6], (bf16_t*)(ws + W_W1), 1024, u / 44, u % 44, 2816, 0}; }
    else if (u < T1) { const int v = u - T0; j = TcJob{P.in[15], 1024, nullptr, (bf16_t*)(ws + W_W2), 1408, v / 16, v % 16, 1024, 0}; }
    else if (u < T2) { const int v = u - T1; j = TcJob{P.in[17], 2048, P.in[16], (bf16_t*)(ws + W_W3), 1024, v / 32, v % 32, 4096, 0}; }
    else if (u < T3) { const int v = u - T2; j = TcJob{P.in[20], 2048, P.in[19], (bf16_t*)(ws + W_W3), 1024, v / 32, v % 32, 4096, 2048}; }
    else if (u < T4) { const int v = u - T3; j = TcJob{P.in[27], 1024, nullptr, (bf16_t*)(ws + W_W4), 1024, v / 16, v % 16, 1024, 0}; }
    else { const int v = u - T4; const int bh = v >> 5, w = v & 31, b = bh >> 3, hd = bh & 7;
      j = TcJob{P.in[5] + (size_t)b * 1024 * 1024 + hd * 128, 1024, nullptr, (bf16_t*)(ws + W_VTS) + (size_t)bh * 128 * KS_LD, KS_LD, w >> 1, w & 1, 0, 0}; }
    return j;
  };
  {
    f32x4 tv[4];
    int u = bid;
    TcJob cur = mkjob(u < T5 ? u : 0);
    if (u < T5) tconv_load(cur, tv);
    while (u < T5) {
      tconv_put(tv, tile);
      __syncthreads();
      const int un = u + G;
      TcJob nxt = mkjob(un < T5 ? un : 0);
      if (un < T5) tconv_load(nxt, tv);
      tconv_store(cur, tile);
      __syncthreads();
      cur = nxt; u = un;
    }
  }
  const int gtid = bid * 256 + tid, gthreads = G * 256;
  for (int idx = gtid; idx < 2 * 16 * 96 * 96; idx += gthreads) {
    const int i = idx % 96, j = (idx / 96) % 96, n = (idx / (96 * 96)) & 15, g = idx / (96 * 96 * 16);
    float v = 0.f;
    if (i < RB && j < RB) v = P.in[g ? 12 : 10][((size_t)n * RB + i) * RB + j];
    ((bf16_t*)(ws + W_WG))[idx] = to_bf16(v);
  }
  for (int idx = gtid; idx < 4096 * 32; idx += gthreads) {
    const int pos = idx >> 5, d = idx & 31;
    const float inv = exp2f(-(float)d * (13.287712379549449f / 32.f));
    const float ang = (float)pos * inv;
    const double a = (double)ang;
    const double nrev = rint(a * 0.15915494309189535);
    const float rr = (float)(a - nrev * 6.283185307179586);
    float2 cs; cs.x = __cosf(rr); cs.y = __sinf(rr);
    ((float2*)(ws + W_ROPE))[idx] = cs;
  }
  for (int idx0 = gtid; idx0 < 8 * 1024 * 256; idx0 += 4 * gthreads) {
    f32x4 v[4];
#pragma unroll
    for (int p = 0; p < 4; ++p) { const int idx = idx0 + p * gthreads; if (idx < 8 * 1024 * 256) v[p] = ((const f32x4*)P.in[4])[idx]; }
#pragma unroll
    for (int p = 0; p < 4; ++p) {
      const int idx = idx0 + p * gthreads;
      if (idx < 8 * 1024 * 256) {
        const int b = idx >> 18, rem = idx & 262143;
        u32x2 w; w.x = pk_bf16(v[p][0], v[p][1]); w.y = pk_bf16(v[p][2], v[p][3]);
        *(u32x2*)((bf16_t*)(ws + W_KBS) + (size_t)b * KS_LD * 1024 + (size_t)rem * 4) = w;
      }
    }
  }
  for (int idx = gtid; idx < 8 * 48 * 512; idx += gthreads) {
    const int b = idx / (48 * 512), rem = idx % (48 * 512);
    ((unsigned*)((bf16_t*)(ws + W_KBS) + (size_t)b * KS_LD * 1024 + (size_t)1040 * 1024))[rem] = 0u;
  }
  for (int idx = gtid; idx < 64 * 128 * 24; idx += gthreads) {
    const int row = idx / 24, c = idx % 24;
    ((unsigned*)((bf16_t*)(ws + W_VTS) + (size_t)row * KS_LD + 1040))[c] = 0u;
  }
  for (int idx = gtid; idx < MT; idx += gthreads) ((float*)(ws + W_SUMSQ))[idx] = 0.f;
  if (gtid < 4096) ((unsigned*)(ws + W_CTR))[gtid] = 0u;
  for (int row0 = (bid * 4 + wave) * 4; row0 < MT; row0 += G * 16) {
    f32x4 v[4][4];
#pragma unroll
    for (int q = 0; q < 4; ++q) {
      const int row = row0 + q;
      const float* src = row < MP ? P.in[0] + (size_t)row * 1024 : P.in[1] + (size_t)(row - MP) * 1024;
#pragma unroll
      for (int i = 0; i < 4; ++i) v[q][i] = *(const f32x4*)(src + i * 256 + lane * 4);
    }
#pragma unroll
    for (int q = 0; q < 4; ++q) {
      const int row = row0 + q;
      bf16_t* dst = (bf16_t*)(ws + W_S0);
      float ss = 0.f;
#pragma unroll
      for (int i = 0; i < 4; ++i) {
        const f32x4 x = v[q][i];
        ss += x[0] * x[0] + x[1] * x[1] + x[2] * x[2] + x[3] * x[3];
        u32x2 w; w.x = pk_bf16(x[0], x[1]); w.y = pk_bf16(x[2], x[3]);
        *(u32x2*)(dst + ktidx(row, i * 256 + lane * 4, MT)) = w;
      }
#pragma unroll
      for (int o = 32; o; o >>= 1) ss += __shfl_xor(ss, o);
      if (lane == 0) ((float*)(ws + W_RSTD0))[row] = rsqrtf(ss * (1.f / 1024.f) + EPS);
    }
  }
}

constexpr int G_ROW = 64, G_A_BYTES = 256 * G_ROW, G_B_BYTES = 128 * G_ROW, G_STAGE = G_A_BYTES + G_B_BYTES;
static_assert(3 * G_STAGE <= LDS_BYTES, "lds");
#define RAW_BARRIER() do { asm volatile("s_waitcnt lgkmcnt(0)" ::: "memory"); __builtin_amdgcn_s_barrier(); } while (0)

template <int K, int NT, bool PIPE, class Epi>
DI void gemm_phase(const bf16_t* __restrict__ A, const bf16_t* __restrict__ Bt,
                   unsigned char* lds, const Epi& epi, const int vx, const int vl, const int nvx) {
  const int tid = threadIdx.x, lane = tid & 63, wave = tid >> 6;
  const int wf = wave & 1, wt = wave >> 1, r = lane & 31, h = lane >> 5;
  const int lrow = tid >> 2, lc = tid & 3;
  const int nk = K >> 5;
  const int mper = 128 / nvx;
  const int ntl = mper * NT + (vx == 0 ? NT : 0);
  const int cmax = (NT - 1) >> 3;
  for (int li = vl; li < ntl; li += 64) {
    int mt, nt;
    int l2 = li;
    bool samp_tile = false;
    if (vx == 0) { if (li < NT) samp_tile = true; else l2 = li - NT; }
    if (samp_tile) { mt = 128; nt = li; }
    else {
      int c = l2 / (mper * 8); c = c > cmax ? cmax : c;
      const int rem = l2 - c * mper * 8, w = (NT - 8 * c) < 8 ? (NT - 8 * c) : 8, mloc = rem / w;
      nt = 8 * c + rem - mloc * w; mt = vx * mper + mloc;
    }
    const bool full = mt < 128;
    const char* Ab = (const char*)(A + (size_t)mt * 256 * 32);
    const char* Bb = (const char*)(Bt + (size_t)nt * 128 * 32);
    const unsigned loff = (unsigned)(lrow * 32 + lc * 8) * 2u;
    constexpr unsigned AKS = (unsigned)MT * 64u, BKS = (unsigned)NT * 128u * 64u;
    f32x16 acc[2][4];
#pragma unroll
    for (int a = 0; a < 2; ++a)
#pragma unroll
      for (int b = 0; b < 4; ++b)
#pragma unroll
        for (int i = 0; i < 16; ++i) acc[a][b][i] = 0.f;
    {
      const unsigned gsrc = (unsigned)((((wave * 16 + (lane >> 2)) * 32) + (((lane & 3) ^ ((lane >> 4) & 3)) * 8)) * 2);
      const int fr = (r >> 2) & 3;
      const int xo0 = ((0 + h) ^ fr) * 16, xo1 = ((2 + h) ^ fr) * 16;
#define G_GL(kt_, st_, NTI) { \
      _Pragma("unroll") for (int p = 0; p < NTI; ++p) __builtin_amdgcn_global_load_lds((const unsigned*)(Ab + (gsrc + (unsigned)(p * 4096) + (unsigned)(kt_) * AKS)), \
          (unsigned*)(lds + (st_) * G_STAGE + (p * 64 + wave * 16) * 64), 16, 0, 0); \
      _Pragma("unroll") for (int p = 0; p < 2; ++p) __builtin_amdgcn_global_load_lds((const unsigned*)(Bb + (gsrc + (unsigned)(p * 4096) + (unsigned)(kt_) * BKS)), \
          (unsigned*)(lds + (st_) * G_STAGE + G_A_BYTES + (p * 64 + wave * 16) * 64), 16, 0, 0); }
#define G_COMP(st_, NTI) { const unsigned char* sA = lds + (st_) * G_STAGE; const unsigned char* sB = sA + G_A_BYTES; \
      bf16x8 W0[2], X0[NTI], W1[2], X1[NTI]; \
      _Pragma("unroll") for (int q = 0; q < 2; ++q) { W0[q] = *(const bf16x8*)(sB + (wf * 64 + q * 32 + r) * 64 + xo0); W1[q] = *(const bf16x8*)(sB + (wf * 64 + q * 32 + r) * 64 + xo1); } \
      _Pragma("unroll") for (int q = 0; q < NTI; ++q) { X0[q] = *(const bf16x8*)(sA + ((2 * q + wt) * 32 + r) * 64 + xo0); X1[q] = *(const bf16x8*)(sA + ((2 * q + wt) * 32 + r) * 64 + xo1); } \
      _Pragma("unroll") for (int ti = 0; ti < NTI; ++ti) _Pragma("unroll") for (int fi = 0; fi < 2; ++fi) acc[fi][ti] = MFMA32(W0[fi], X0[ti], acc[fi][ti]); \
      _Pragma("unroll") for (int ti = 0; ti < NTI; ++ti) _Pragma("unroll") for (int fi = 0; fi < 2; ++fi) acc[fi][ti] = MFMA32(W1[fi], X1[ti], acc[fi][ti]); }
#define G_KLOOP(NTI, WAITN) { \
      G_GL(0, 0, NTI) \
      G_GL(1, 1, NTI) \
      int st = 0, st2 = 2; \
      for (int kt = 0; kt < nk; ++kt) { \
        if (kt + 1 < nk) asm volatile("s_waitcnt vmcnt(" #WAITN ")" ::: "memory"); else asm volatile("s_waitcnt vmcnt(0)" ::: "memory"); \
        RAW_BARRIER(); \
        if (kt + 2 < nk) G_GL(kt + 2, st2, NTI) \
        G_COMP(st, NTI) \
        st = st == 2 ? 0 : st + 1; st2 = st2 == 2 ? 0 : st2 + 1; \
      } }
      if (full) G_KLOOP(4, 6) else G_KLOOP(2, 4)
#undef G_KLOOP
#undef G_COMP
#undef G_GL
    }
    __syncthreads();
    epi(acc, mt, nt, wf, wt, r, h);
    __syncthreads();
  }
}

constexpr int ST_OFF = 0, ST_LD = 68, ST_WAVE = 32 * ST_LD * 4;
static_assert(ST_OFF + 4 * ST_WAVE <= LDS_BYTES, "lds");
#define WAVE_LDS_FENCE() __syncthreads()
DI float* stage_buf(unsigned char* lds) { return (float*)(lds + ST_OFF + (threadIdx.x >> 6) * ST_WAVE); }
DI void stage_put(float* wb, const f32x16& a0, const f32x16& a1, int r, int h) {
#pragma unroll
  for (int g = 0; g < 4; ++g) {
    *(f32x4*)(wb + r * ST_LD + 8 * g + 4 * h) = (f32x4){a0[4 * g], a0[4 * g + 1], a0[4 * g + 2], a0[4 * g + 3]};
    *(f32x4*)(wb + r * ST_LD + 32 + 8 * g + 4 * h) = (f32x4){a1[4 * g], a1[4 * g + 1], a1[4 * g + 2], a1[4 * g + 3]};
  }
}
DI u32x4 pack8(const f32x4& x0, const f32x4& x1) {
  u32x4 w; w[0] = pk_bf16(x0[0], x0[1]); w[1] = pk_bf16(x0[2], x0[3]); w[2] = pk_bf16(x1[0], x1[1]); w[3] = pk_bf16(x1[2], x1[3]); return w;
}

struct Epi1 {
  const float* rstd0; bf16_t* upre; bf16_t* sg; unsigned char* lds;
  DI void operator()(const f32x16 (&acc)[2][4], int mt, int nt, int wf, int wt, int r, int h) const {
    const bool isg = nt >= 11;
    const int lane = threadIdx.x & 63;
    float* wb = stage_buf(lds);
    bf16_t* dst = (isg ? sg : upre) + (isg ? nt - 11 : nt) * 128 + wf * 64;
    const int nti = mt < 128 ? 4 : 2;
    float rsv[4];
#pragma unroll
    for (int ti = 0; ti < 4; ++ti) rsv[ti] = ti < nti ? rstd0[mt * 256 + (2 * ti + wt) * 32 + r] : 0.f;
#pragma unroll
    for (int ti = 0; ti < 4; ++ti) {
      if (ti < nti) {
        const int base = mt * 256 + (2 * ti + wt) * 32;
        const float rs = rsv[ti];
        f32x16 a0, a1;
#pragma unroll
        for (int i = 0; i < 16; ++i) {
          float v0 = acc[0][ti][i] * rs, v1 = acc[1][ti][i] * rs;
          if (isg) { v0 = siluf_(v0); v1 = siluf_(v1); }
          a0[i] = v0; a1[i] = v1;
        }
        stage_put(wb, a0, a1, r, h);
        WAVE_LDS_FENCE();
#pragma unroll
        for (int k = 0; k < 4; ++k) {
          const int row = 8 * k + (lane >> 3), c = (lane & 7) * 8;
          const f32x4 x0 = *(const f32x4*)(wb + row * ST_LD + c), x1 = *(const f32x4*)(wb + row * ST_LD + c + 4);
          *(u32x4*)(dst + (size_t)(base + row) * DRNN + c) = pack8(x0, x1);
        }
        WAVE_LDS_FENCE();
      }
    }
  }
};

struct Epi2 {
  const float* xp; const float* xs; float* yp; float* ys; bf16_t* x1b; float* sumsq; unsigned char* lds;
  DI void operator()(const f32x16 (&acc)[2][4], int mt, int nt, int wf, int wt, int r, int h) const {
    const int lane = threadIdx.x & 63;
    float* wb = stage_buf(lds);
    const int nti = mt < 128 ? 4 : 2;
    const int f0 = nt * 128 + wf * 64;
    const float* xbase = mt < 128 ? xp : xs - (size_t)MP * 1024;
    float* ybase = mt < 128 ? yp : ys - (size_t)MP * 1024;
#pragma unroll
    for (int ti = 0; ti < 4; ++ti) {
      if (ti < nti) {
        const int base = mt * 256 + (2 * ti + wt) * 32;
        stage_put(wb, acc[0][ti], acc[1][ti], r, h);
        WAVE_LDS_FENCE();
        f32x4 xv[8];
#pragma unroll
        for (int k = 0; k < 8; ++k) xv[k] = *(const f32x4*)(xbase + (size_t)(base + 4 * k + (lane >> 4)) * 1024 + f0 + (lane & 15) * 4);
#pragma unroll
        for (int k = 0; k < 8; ++k) {
          const int row = 4 * k + (lane >> 4), c = (lane & 15) * 4;
          const int token = base + row;
          const f32x4 a = *(const f32x4*)(wb + row * ST_LD + c);
          float* yr = ybase + (size_t)token * 1024;
          const f32x4 v = a + xv[k];
          *(f32x4*)(yr + f0 + c) = v;
          u32x2 w; w.x = pk_bf16(v[0], v[1]); w.y = pk_bf16(v[2], v[3]);
          *(u32x2*)(x1b + ktidx(token, f0 + c, MT)) = w;
          float ss = v[0] * v[0] + v[1] * v[1] + v[2] * v[2] + v[3] * v[3];
          ss += __shfl_xor(ss, 1); ss += __shfl_xor(ss, 2); ss += __shfl_xor(ss, 4); ss += __shfl_xor(ss, 8);
          if ((lane & 15) == 0) atomicAdd(sumsq + token, ss);
        }
        WAVE_LDS_FENCE();
      }
    }
  }
};

DI void xchg_store16(bf16_t* p8  , const u32x2& wA, const u32x2& wB, const int h) {
  const u32x2 snd = h ? wA : wB;
  u32x2 rcv; rcv.x = (unsigned)__shfl_xor((int)snd.x, 32); rcv.y = (unsigned)__shfl_xor((int)snd.y, 32);
  const u32x4 o4 = h ? (u32x4){rcv.x, rcv.y, wB.x, wB.y} : (u32x4){wA.x, wA.y, rcv.x, rcv.y};
  *(u32x4*)(p8 + 8 * h) = o4;
}

struct Epi3 {
  const float* sumsq; const float* knorm; const float* qnorm; const float2* rope;
  float* kp; float* vp; float* ks; float* vs;
  bf16_t* kbp; bf16_t* vtp; bf16_t* kbs; bf16_t* vts; bf16_t* qb; bf16_t* sgb;
  DI void operator()(const f32x16 (&acc)[2][4], int mt, int nt, int wf, int wt, int r, int h) const {
    const int sec = nt >> 3, head = nt & 7;
#pragma unroll
    for (int ti = 0; ti < 4; ++ti) {
      const int token = mt * 256 + (2 * ti + wt) * 32 + r;
      if (token >= MT) continue;
      const bool samp = token >= MP;
      const int sidx = token - MP;
      const int b = samp ? (sidx >> 4) : (token >> 12);
      const int t = samp ? (sidx & 15) : (token & 4095);
      const int pos = samp ? PAST + t : t;
      const float rs1 = rsqrtf(sumsq[token] * (1.f / 1024.f) + EPS);
      if (sec == 0 || sec == 2) {
        const float* gn = sec == 0 ? knorm : qnorm;
        float ss = 0.f;
#pragma unroll
        for (int fi = 0; fi < 2; ++fi)
#pragma unroll
          for (int i = 0; i < 16; ++i) { const float v = acc[fi][ti][i] * rs1; ss += v * v; }
        ss += __shfl_xor(ss, 32);
        const float rs = rs1 * rsqrtf(ss * (1.f / 64.f) + EPS);
        const float2* rp = rope + (size_t)pos * 32;
#pragma unroll
        for (int gp = 0; gp < 4; gp += 2) {
          u32x2 w1[2], w2[2];
#pragma unroll
          for (int k2 = 0; k2 < 2; ++k2) {
            const int g = gp + k2;
            const int d0 = 8 * g + 4 * h;
            const f32x4 g1 = *(const f32x4*)(gn + d0), g2 = *(const f32x4*)(gn + 32 + d0);
            const f32x4 cs01 = *(const f32x4*)(rp + d0), cs23 = *(const f32x4*)(rp + d0 + 2);
            const float cc[4] = {cs01[0], cs01[2], cs23[0], cs23[2]}, sn[4] = {cs01[1], cs01[3], cs23[1], cs23[3]};
            f32x4 o1, o2;
#pragma unroll
            for (int q = 0; q < 4; ++q) {
              const float x1 = acc[0][ti][4 * g + q] * rs * g1[q], x2 = acc[1][ti][4 * g + q] * rs * g2[q];
              o1[q] = x1 * cc[q] - x2 * sn[q];
              o2[q] = x2 * cc[q] + x1 * sn[q];
            }
            if (sec == 0) {
              float* ko = samp ? ks + (size_t)sidx * 1024 : kp + (size_t)token * 1024;
              const int col = head * 128 + wf * 64 + d0;
              *(f32x4*)(ko + col) = o1; *(f32x4*)(ko + col + 32) = o2;
              w1[k2].x = pk_bf16(o1[0], o1[1]); w1[k2].y = pk_bf16(o1[2], o1[3]); w2[k2].x = pk_bf16(o2[0], o2[1]); w2[k2].y = pk_bf16(o2[2], o2[3]);
            } else {
              w1[k2].x = pk_bf16(o1[0] * QSCALE, o1[1] * QSCALE); w1[k2].y = pk_bf16(o1[2] * QSCALE, o1[3] * QSCALE);
              w2[k2].x = pk_bf16(o2[0] * QSCALE, o2[1] * QSCALE); w2[k2].y = pk_bf16(o2[2] * QSCALE, o2[3] * QSCALE);
            }
          }
          bf16_t* brow = sec == 0 ? (samp ? kbs + ((size_t)b * KS_LD + PAST + t) * 1024 : kbp + (size_t)token * 1024) : qb + (size_t)token * 1024;
          bf16_t* p8 = brow + head * 128 + wf * 64 + 8 * gp;
          xchg_store16(p8, w1[0], w1[1], h);
          xchg_store16(p8 + 32, w2[0], w2[1], h);
        }
      } else if (sec == 1) {
        float* vo = samp ? vs + (size_t)sidx * 1024 : vp + (size_t)token * 1024;
        bf16_t* vt = samp ? vts + (size_t)(b * 8 + head) * 128 * KS_LD + PAST + t : vtp + (size_t)(b * 8 + head) * 128 * SEQ + t;
        const int vld = samp ? KS_LD : SEQ;
#pragma unroll
        for (int fi = 0; fi < 2; ++fi)
#pragma unroll
          for (int g = 0; g < 4; ++g) {
            const int e0 = wf * 64 + fi * 32 + 8 * g + 4 * h;
            f32x4 v;
#pragma unroll
            for (int q = 0; q < 4; ++q) { v[q] = acc[fi][ti][4 * g + q] * rs1; vt[(size_t)(e0 + q) * vld] = to_bf16(v[q]); }
            *(f32x4*)(vo + head * 128 + e0) = v;
          }
      } else {
        bf16_t* so = sgb + (size_t)token * 1024 + head * 128;
#pragma unroll
        for (int fi = 0; fi < 2; ++fi)
#pragma unroll
          for (int gp = 0; gp < 4; gp += 2) {
            u32x2 w[2];
#pragma unroll
            for (int k2 = 0; k2 < 2; ++k2) {
              const int g = gp + k2;
              w[k2].x = pk_bf16(siluf_(acc[fi][ti][4 * g] * rs1), siluf_(acc[fi][ti][4 * g + 1] * rs1));
              w[k2].y = pk_bf16(siluf_(acc[fi][ti][4 * g + 2] * rs1), siluf_(acc[fi][ti][4 * g + 3] * rs1));
            }
            xchg_store16(so + wf * 64 + fi * 32 + 8 * gp, w[0], w[1], h);
          }
      }
    }
  }
};

struct Epi4 {
  float* yp; float* ys; unsigned char* lds;
  DI void operator()(const f32x16 (&acc)[2][4], int mt, int nt, int wf, int wt, int r, int h) const {
    const int lane = threadIdx.x & 63;
    float* wb = stage_buf(lds);
    const int nti = mt < 128 ? 4 : 2;
    const int f0 = nt * 128 + wf * 64;
#pragma unroll
    for (int ti = 0; ti < 4; ++ti) {
      if (ti < nti) {
        const int base = mt * 256 + (2 * ti + wt) * 32;
        stage_put(wb, acc[0][ti], acc[1][ti], r, h);
        WAVE_LDS_FENCE();
        float* ybase = mt < 128 ? yp : ys - (size_t)MP * 1024;
        f32x4 yv[8];
#pragma unroll
        for (int k = 0; k < 8; ++k) yv[k] = *(const f32x4*)(ybase + (size_t)(base + 4 * k + (lane >> 4)) * 1024 + f0 + (lane & 15) * 4);
#pragma unroll
        for (int k = 0; k < 8; ++k) {
          const int row = 4 * k + (lane >> 4), c = (lane & 15) * 4;
          const f32x4 a = *(const f32x4*)(wb + row * ST_LD + c);
          *(f32x4*)(ybase + (size_t)(base + row) * 1024 + f0 + c) = a + yv[k];
        }
        WAVE_LDS_FENCE();
      }
    }
  }
};

constexpr int R_RAW = 0, R_U = 11808, R_UF = R_U + 64 * 208, R_C = R_UF + 64 * 48 * 4, R_AGG = R_C + 3 * 48 * 4, R_MISC = R_AGG + 2 * 4 * 48 * 4, R_WL = R_MISC + 16;
static_assert(R_WL + 2 * 48 * 208 <= LDS_BYTES, "lds");
template <int N> DI float row_shr(float oldv, float v) {
  return __builtin_bit_cast(float, __builtin_amdgcn_update_dpp(__builtin_bit_cast(int, oldv), __builtin_bit_cast(int, v), 0x110 + N, 0xF, 0xF, false));
}

DI void rec_item(const Params& P, unsigned char* lds, const int item) {
  const int tid = threadIdx.x, lane = tid & 63, wave = tid >> 6;
  const int quad = lane >> 4, tok_l = lane & 15;
  unsigned char* ws = P.ws;
  const bf16_t* upre = (const bf16_t*)(ws + W_S1);
  const bf16_t* sg = (const bf16_t*)(ws + W_S2);
  bf16_t* yg = (bf16_t*)(ws + W_S3);
  const bf16_t* wg = (const bf16_t*)(ws + W_WG);
  unsigned* raw32 = (unsigned*)(lds + R_RAW);
  const bf16_t* raw = (const bf16_t*)(lds + R_RAW);
  unsigned char* Ub = lds + R_U;
  float* Uf = (float*)(lds + R_UF);
  float* Cc = (float*)(lds + R_C);
  float* aggA = (float*)(lds + R_AGG);
  float* aggB = aggA + 4 * 48;
  const bool samp = item >= 256;
  const int it = item & 255, jhalf = it & 1, n = (it >> 1) & 15, b = it >> 5;
  const int T = samp ? 16 : SEQ, nchunks = samp ? 1 : 64;
  const int seqbase = samp ? MP + b * 16 : b * SEQ;
  const int tmax = samp ? 16 : 64;
  const int j0 = jhalf * 48;
  unsigned char* Wl = lds + R_WL;
  for (int idx = tid; idx < 2 * 48 * 12; idx += 256) {
    const int g = idx / 576, rem = idx - g * 576, j = rem / 12, kc = rem - j * 12;
    *(u32x4*)(Wl + (g * 48 + j) * 208 + kc * 16) = *(const u32x4*)(wg + ((size_t)(g * 16 + n) * 96 + j0 + j) * 96 + kc * 8);
  }
  if (tid < 48) {
    const int jj = j0 + tid; const bool valid = jj < RB; const int ch = n * RB + jj;
    Cc[tid] = valid ? P.in[11][ch] : 0.f;
    Cc[48 + tid] = valid ? P.in[13][ch] : 0.f;
    float sp = 0.f;
    if (valid) { const float z = -P.in[14][ch]; sp = z > 15.f ? z : log1pf(__expf(z)); }
    Cc[96 + tid] = -8.f * sp;
  }
  for (int idx = tid; idx < 64 * 8; idx += 256) *(unsigned*)(Ub + (idx >> 3) * 208 + 176 + (idx & 7) * 4) = 0u;
  float hc[3][4];
#pragma unroll
  for (int jt = 0; jt < 3; ++jt)
#pragma unroll
    for (int q = 0; q < 4; ++q) {
      const int jj = j0 + jt * 16 + quad * 4 + q;
      hc[jt][q] = (samp && jj < RB) ? P.in[3][(size_t)b * DRNN + n * RB + jj] : 0.f;
    }
  const int cp = tid % 44, ctg = tid / 44;
  float cw[4][2], cbias[2];
#pragma unroll
  for (int k = 0; k < 4; ++k) { cw[k][0] = 0.f; cw[k][1] = 0.f; }
  cbias[0] = cbias[1] = 0.f;
  if (tid < 176) {
    const int ch = n * RB + 2 * cp;
#pragma unroll
    for (int k = 0; k < 4; ++k) { cw[k][0] = P.in[8][k * DRNN + ch]; cw[k][1] = P.in[8][k * DRNN + ch + 1]; }
    cbias[0] = P.in[9][ch]; cbias[1] = P.in[9][ch + 1];
  }
  u32x4 praw[3]; u32x2 psg[3];
  auto load_chunk = [&](int ci) {
    const int t0 = ci * 64;
#pragma unroll
    for (int p = 0; p < 3; ++p) {
      const int idx = p * 256 + tid;
      u32x4 v = {0u, 0u, 0u, 0u};
      if (idx < 737) {
        const int row = idx / 11, pc = idx - row * 11, trow = t0 - 3 + row;
        if (trow >= 0) {
          if (trow < T) v = *(const u32x4*)(upre + (size_t)(seqbase + trow) * DRNN + n * RB + pc * 8);
        } else if (samp) {
          const float* sp = P.in[2] + ((size_t)b * 3 + (3 + trow)) * DRNN + n * RB + pc * 8;
          const f32x4 a = *(const f32x4*)sp, c = *(const f32x4*)(sp + 4);
          v[0] = pk_bf16(a[0], a[1]); v[1] = pk_bf16(a[2], a[3]); v[2] = pk_bf16(c[0], c[1]); v[3] = pk_bf16(c[2], c[3]);
        }
      }
      praw[p] = v;
      u32x2 sv = {0u, 0u};
      const int tt = t0 + wave * 16 + tok_l, ch0 = j0 + p * 16 + quad * 4;
      if (ch0 < RB && tt < T) sv = *(const u32x2*)(sg + (size_t)(seqbase + tt) * DRNN + n * RB + ch0);
      psg[p] = sv;
    }
  };
  load_chunk(0);
  for (int ci = 0; ci < nchunks; ++ci) {
    u32x2 sgc[3];
#pragma unroll
    for (int p = 0; p < 3; ++p) {
      const int idx = p * 256 + tid;
      if (idx < 737) *(u32x4*)(lds + R_RAW + idx * 16) = praw[p];
      sgc[p] = psg[p];
    }
    __syncthreads();
    if (ci + 1 < nchunks) load_chunk(ci + 1);
    if (tid < 176) {
      const int tb = ctg * 16;
      unsigned x0 = raw32[(tb + 0) * 44 + cp], x1 = raw32[(tb + 1) * 44 + cp], x2 = raw32[(tb + 2) * 44 + cp];
      const int cl = 2 * cp - j0;
      const bool mine = cl >= 0 && cl < 48;
#pragma unroll
      for (int t = 0; t < 16; ++t) {
        const unsigned x3 = raw32[(tb + t + 3) * 44 + cp];
        const float u0 = cbias[0] + cw[0][0] * bf_lo(x0) + cw[1][0] * bf_lo(x1) + cw[2][0] * bf_lo(x2) + cw[3][0] * bf_lo(x3);
        const float u1 = cbias[1] + cw[0][1] * bf_hi(x0) + cw[1][1] * bf_hi(x1) + cw[2][1] * bf_hi(x2) + cw[3][1] * bf_hi(x3);
        *(unsigned*)(Ub + (tb + t) * 208 + cp * 4) = pk_bf16(u0, u1);
        if (mine) { float2 uu; uu.x = u0; uu.y = u1; *(float2*)(Uf + (tb + t) * 48 + cl) = uu; }
        x0 = x1; x1 = x2; x2 = x3;
      }
    }
    if (ci == nchunks - 1 && jhalf == 0) {
      float* co = P.out + (samp ? O_CONVS : O_CONVP) + (size_t)b * 3 * DRNN + n * RB;
      for (int idx = tid; idx < 3 * RB; idx += 256) { const int jr = idx / RB, c = idx - jr * RB; co[(size_t)jr * DRNN + c] = bf_to_f(raw[(tmax + jr) * RB + c]); }
    }
    __syncthreads();
    const int tch = wave * 16 + tok_l;
    float av[3][4], bv[3][4];
    {
      bf16x8 uf[3];
#pragma unroll
      for (int ks = 0; ks < 3; ++ks) uf[ks] = *(const bf16x8*)(Ub + tch * 208 + ks * 64 + quad * 16);
      const bool first = (!samp) && ci == 0 && tch == 0;
      const bool tvalid = tch < tmax;
#pragma unroll
      for (int jt = 0; jt < 3; ++jt) {
        f32x4 ar = {0.f, 0.f, 0.f, 0.f}, ai = {0.f, 0.f, 0.f, 0.f};
#pragma unroll
        for (int ks = 0; ks < 3; ++ks) {
          const bf16x8 wrf = *(const bf16x8*)(Wl + (jt * 16 + tok_l) * 208 + ks * 64 + quad * 16);
          const bf16x8 wif = *(const bf16x8*)(Wl + (48 + jt * 16 + tok_l) * 208 + ks * 64 + quad * 16);
          ar = MFMA16(wrf, uf[ks], ar); ai = MFMA16(wif, uf[ks], ai);
        }
        const f32x4 cbr = *(const f32x4*)(Cc + jt * 16 + quad * 4), cbi = *(const f32x4*)(Cc + 48 + jt * 16 + quad * 4);
        const f32x4 ccs = *(const f32x4*)(Cc + 96 + jt * 16 + quad * 4), uu = *(const f32x4*)(Uf + tch * 48 + jt * 16 + quad * 4);
#pragma unroll
        for (int q = 0; q < 4; ++q) {
          const float rr = sigmoidf_(ar[q] + cbr[q]);
          const float ii = sigmoidf_(ai[q] + cbi[q]);
          const float la = ccs[q] * rr;
          const float a = fexp(la);
          const float x2 = 2.f * la;
          const float e2 = x2 > -0.1f ? -x2 * (1.f + x2 * (0.5f + x2 * ((1.f / 6.f) + x2 * (1.f / 24.f)))) : 1.f - a * a;
          float mult = __builtin_amdgcn_sqrtf(e2);
          if (first) mult = 1.f;
          av[jt][q] = tvalid ? a : 1.f;
          bv[jt][q] = tvalid ? mult * ii * uu[q] : 0.f;
        }
      }
    }
#define SCAN_STEP(N) { const float ap = row_shr<N>(1.f, a), bp = row_shr<N>(0.f, bb); bb = fmaf(a, bp, bb); a = a * ap; }
#pragma unroll
    for (int jt = 0; jt < 3; ++jt) {
#pragma unroll
      for (int q = 0; q < 4; ++q) {
        float a = av[jt][q], bb = bv[jt][q];
        SCAN_STEP(1) SCAN_STEP(2) SCAN_STEP(4) SCAN_STEP(8)
        av[jt][q] = a; bv[jt][q] = bb;
      }
      if (tok_l == 15) {
        *(f32x4*)(aggA + wave * 48 + jt * 16 + quad * 4) = (f32x4){av[jt][0], av[jt][1], av[jt][2], av[jt][3]};
        *(f32x4*)(aggB + wave * 48 + jt * 16 + quad * 4) = (f32x4){bv[jt][0], bv[jt][1], bv[jt][2], bv[jt][3]};
      }
    }
#undef SCAN_STEP
    __syncthreads();
#pragma unroll
    for (int jt = 0; jt < 3; ++jt) {
      float c[4] = {hc[jt][0], hc[jt][1], hc[jt][2], hc[jt][3]}, cin[4] = {0.f, 0.f, 0.f, 0.f};
#pragma unroll
      for (int w2 = 0; w2 < 4; ++w2) {
        const f32x4 A4 = *(const f32x4*)(aggA + w2 * 48 + jt * 16 + quad * 4), B4 = *(const f32x4*)(aggB + w2 * 48 + jt * 16 + quad * 4);
#pragma unroll
        for (int q = 0; q < 4; ++q) { if (w2 == wave) cin[q] = c[q]; c[q] = fmaf(A4[q], c[q], B4[q]); }
      }
      float hv[4];
#pragma unroll
      for (int q = 0; q < 4; ++q) { hc[jt][q] = c[q]; hv[q] = fmaf(av[jt][q], cin[q], bv[jt][q]); }
      const int ch0 = j0 + jt * 16 + quad * 4;
      if (ch0 < RB && tch < tmax) {
        u32x2 w;
        w.x = pk_bf16(hv[0] * bf_lo(sgc[jt].x), hv[1] * bf_hi(sgc[jt].x));
        w.y = pk_bf16(hv[2] * bf_lo(sgc[jt].y), hv[3] * bf_hi(sgc[jt].y));
        *(u32x2*)(yg + ktidx(seqbase + ci * 64 + tch, n * RB + ch0, MT)) = w;
      }
    }
  }
  if (wave == 0 && tok_l == 0) {
#pragma unroll
    for (int jt = 0; jt < 3; ++jt)
#pragma unroll
      for (int q = 0; q < 4; ++q) {
        const int jj = j0 + jt * 16 + quad * 4 + q;
        if (jj < RB) P.out[(samp ? O_HS : O_HP) + (size_t)b * DRNN + n * RB + jj] = hc[jt][q];
      }
  }
}

DI void rec_phase(const Params& P, unsigned char* lds) {
  const int tid = threadIdx.x;
  unsigned* ctr = (unsigned*)(P.ws + W_CTR);
  volatile int* sh = (volatile int*)(lds + R_MISC);
  if (tid == 0) {
    const unsigned hw = __builtin_amdgcn_s_getreg(0xF804), xcc = __builtin_amdgcn_s_getreg(0xF814);
    const unsigned key = ((xcc & 7u) << 8) | ((hw >> 8) & 0xFFu);
    sh[0] = (int)atomicAdd(ctr + 64 + key, 1u);
  }
  __syncthreads();
  const int rank = sh[0];
  for (int pass = 0; pass < 2; ++pass) {
    const bool longq = (pass == 0) == (rank == 0);
    for (;;) {
      __syncthreads();
      if (tid == 0) sh[1] = (int)atomicAdd(ctr + 16 + (longq ? 0 : 1), 1u);
      __syncthreads();
      const int idx = sh[1];
      if (idx >= 256) break;
      rec_item(P, lds, longq ? idx : 256 + idx);
    }
  }
}

constexpr int AK_ROW = 256, AK_BYTES = 64 * AK_ROW, AV_ROW = 128, AV_BYTES = 128 * AV_ROW, A_STAGE = AK_BYTES + AV_BYTES;
static_assert(2 * A_STAGE + 16 <= LDS_BYTES, "lds");

DI void attn_phase(const Params& P, unsigned char* lds, int rep, const int vx) {
  const int tid = threadIdx.x, lane = tid & 63, wave = tid >> 6;
  const int r = lane & 31, h = lane >> 5;
  const int c = wave & 1, g = wave >> 1;
  unsigned char* ws = P.ws;
  const bf16_t* qb = (const bf16_t*)(ws + W_S3);
  const bf16_t* sgb = (const bf16_t*)(ws + W_S4);
  bf16_t* og = (bf16_t*)(ws + W_S0);
  unsigned* ctr = (unsigned*)(ws + W_CTR) + rep * 8;
  volatile int* s_item = (volatile int*)(lds + 2 * A_STAGE);
  float lam;
  {
    float v1 = P.in[22][lane] * P.in[23][lane], v2 = P.in[24][lane] * P.in[25][lane];
#pragma unroll
    for (int o = 32; o; o >>= 1) { v1 += __shfl_xor(v1, o); v2 += __shfl_xor(v2, o); }
    lam = expf(v1) - expf(v2) + LAM_INIT;
  }
  float kmax;
  {
    float gm = fabsf(P.in[18][lane]);
#pragma unroll
    for (int o = 32; o; o >>= 1) gm = fmaxf(gm, __shfl_xor(gm, o));
    kmax = 8.f * gm * 1.02f;
  }
  int q = vx & 7, tries = 0;
  while (tries < 8) {
    if (tid == 0) *s_item = (int)atomicAdd(ctr + q, 1u);
    __syncthreads();
    const int item = *s_item;
    __syncthreads();
    if (item >= 520) { q = (q + 1) & 7; ++tries; continue; }
    const int b = q;
    const bool samp = item < 8;
    int head, nkt, nkeys, qrow0, nq, kld_rows; const bf16_t* kbase; const bf16_t* vbase; int vld;
    if (samp) {
      head = item; nkt = 17; nkeys = 1040; qrow0 = MP + b * 16; nq = 16;
      kbase = (const bf16_t*)(ws + W_KBS) + (size_t)b * KS_LD * 1024 + head * 128;
      vbase = (const bf16_t*)(ws + W_VTS) + (size_t)(b * 8 + head) * 128 * KS_LD; vld = KS_LD;
    } else {
      const int p = item - 8; head = p >> 6; const int chunk = 63 - (p & 63);
      nkt = chunk + 1; nkeys = nkt * 64; qrow0 = b * SEQ + chunk * 64; nq = 64;
      kbase = (const bf16_t*)(ws + W_S1) + (size_t)b * SEQ * 1024 + head * 128;
      vbase = (const bf16_t*)(ws + W_S2) + (size_t)(b * 8 + head) * 128 * SEQ; vld = SEQ;
    }
    (void)kld_rows;
    const bool active = g * 32 < nq;
    int qtok = qrow0 + g * 32 + r; if (qtok > MT - 1) qtok = MT - 1;
    bf16x8 qf[4];
#pragma unroll
    for (int s = 0; s < 4; ++s) qf[s] = *(const bf16x8*)(qb + (size_t)qtok * 1024 + head * 128 + c * 64 + s * 16 + h * 8);
    f32x16 oacc[4];
#pragma unroll
    for (int et = 0; et < 4; ++et)
#pragma unroll
      for (int i = 0; i < 16; ++i) oacc[et][i] = 0.f;
    float mref = 0.f, lsum = 0.f;
    bool fixed_shift = false;
    if (!samp) {
      float qn = 0.f;
#pragma unroll
      for (int s4 = 0; s4 < 4; ++s4)
#pragma unroll
        for (int j = 0; j < 8; ++j) { const float qv = bf_to_f((bf16_t)qf[s4][j]); qn += qv * qv; }
      qn += __shfl_xor(qn, 32);
      const float bnd = __builtin_amdgcn_sqrtf(qn) * kmax + 0.05f;
      fixed_shift = !__any(bnd > 50.f);
      if (fixed_shift) mref = bnd;
    }
    const int klr = wave * 4 + (lane >> 4);
    const int kperm = (klr & 3) | ((klr & 4) << 1) | ((klr & 8) >> 1);
    const bf16_t* kg = kbase + (size_t)kperm * 1024 + (((lane & 15) ^ klr) * 8);
    const int vlr = wave * 8 + (lane >> 3);
    const bf16_t* vg = vbase + (size_t)vlr * vld + (((lane & 7) ^ ((vlr >> 1) & 7)) * 8);
#define A_GL(kt_, st_) { _Pragma("unroll") for (int p = 0; p < 4; ++p) { \
      __builtin_amdgcn_global_load_lds((const unsigned*)(kg + ((size_t)(kt_) * 64 + p * 16) * 1024), (unsigned*)(lds + (st_) * A_STAGE + (p * 16 + wave * 4) * 256), 16, 0, 0); \
      __builtin_amdgcn_global_load_lds((const unsigned*)(vg + (size_t)p * 32 * vld + (kt_) * 64), (unsigned*)(lds + (st_) * A_STAGE + AK_BYTES + (p * 32 + wave * 8) * 128), 16, 0, 0); } }
    A_GL(0, 0)
    const int kx = r & 15, vx7 = (r >> 1) & 7;
    for (int kt = 0; kt < nkt; ++kt) {
      const int cur = kt & 1;
      asm volatile("s_waitcnt vmcnt(0)" ::: "memory");
      RAW_BARRIER();
      if (kt + 1 < nkt) A_GL(kt + 1, cur ^ 1)
      if (active) {
        const unsigned char* sK = lds + cur * A_STAGE;
        const unsigned char* sV = sK + AK_BYTES;
        f32x16 sacc[2];
        const float nmref = -mref;
#pragma unroll
        for (int ks = 0; ks < 2; ++ks) {
#pragma unroll
          for (int i = 0; i < 16; ++i) sacc[ks][i] = nmref;
#pragma unroll
          for (int s = 0; s < 4; ++s) {
            const bf16x8 kf = *(const bf16x8*)(sK + (ks * 32 + r) * AK_ROW + (((c * 8 + 2 * s + h) ^ kx) * 16));
            sacc[ks] = MFMA32(kf, qf[s], sacc[ks]);
          }
        }
        if (kt * 64 + 64 > nkeys) {
#pragma unroll
          for (int ks = 0; ks < 2; ++ks)
#pragma unroll
            for (int i = 0; i < 16; ++i) if (kt * 64 + ks * 32 + 16 * (i >> 3) + 8 * h + 4 * ((i >> 2) & 1) + (i & 3) >= nkeys) sacc[ks][i] = -INFINITY;
        }
        if (!fixed_shift) {
        float mx = sacc[0][0];
#pragma unroll
        for (int ks = 0; ks < 2; ++ks)
#pragma unroll
          for (int i = 0; i < 16; ++i) mx = fmaxf(mx, sacc[ks][i]);
        mx = fmaxf(mx, __shfl_xor(mx, 32));
        if (__any(fabsf(mx) > 8.f)) {
          const float alpha = fexp2(-mx);
          mref += mx; lsum *= alpha;
#pragma unroll
          for (int et = 0; et < 4; ++et)
#pragma unroll
            for (int i = 0; i < 16; ++i) oacc[et][i] *= alpha;
#pragma unroll
          for (int ks = 0; ks < 2; ++ks)
#pragma unroll
            for (int i = 0; i < 16; ++i) sacc[ks][i] -= mx;
        }
        }
        float psum = 0.f;
#pragma unroll
        for (int ks = 0; ks < 2; ++ks)
#pragma unroll
          for (int i = 0; i < 16; ++i) { const float pv = fexp2(sacc[ks][i]); sacc[ks][i] = pv; psum += pv; }
        lsum += psum;
#pragma unroll
        for (int ks = 0; ks < 2; ++ks)
#pragma unroll
          for (int sp = 0; sp < 2; ++sp) {
            const bf16x8 pf = pack8_mfma(sacc[ks][8 * sp + 0], sacc[ks][8 * sp + 1], sacc[ks][8 * sp + 2], sacc[ks][8 * sp + 3],
                                         sacc[ks][8 * sp + 4], sacc[ks][8 * sp + 5], sacc[ks][8 * sp + 6], sacc[ks][8 * sp + 7]);
#pragma unroll
            for (int et = 0; et < 4; ++et) {
              const bf16x8 vf = *(const bf16x8*)(sV + (et * 32 + r) * AV_ROW + ((((ks * 2 + sp) * 2 + h) ^ vx7) * 16));
              oacc[et] = MFMA32(vf, pf, oacc[et]);
            }
          }
      }
    }
#undef A_GL
    __syncthreads();
    const float ltot = lsum + __shfl_xor(lsum, 32);
    const float inv = active ? fast_rcp(ltot) : 0.f;
    float* xb = (float*)lds + g * 4096;
    if (c == 1 && active) {
      const float sc = inv * lam;
#pragma unroll
      for (int et = 0; et < 4; ++et)
#pragma unroll
        for (int i = 0; i < 16; ++i) xb[(et * 16 + i) * 64 + lane] = oacc[et][i] * sc;
    }
    __syncthreads();
    if (c == 0 && active) {
      float ss = 0.f;
#pragma unroll
      for (int et = 0; et < 4; ++et)
#pragma unroll
        for (int i = 0; i < 16; ++i) { const float o = oacc[et][i] * inv - xb[(et * 16 + i) * 64 + lane]; oacc[et][i] = o; ss += o * o; }
      ss += __shfl_xor(ss, 32);
      const float rs = rsqrtf(ss * (1.f / 128.f) + EPS) * ONE_M_LAM_INIT;
      if (g * 32 + r < nq) {
        const int token = qrow0 + g * 32 + r;
        const bf16_t* sgr = sgb + (size_t)token * 1024 + head * 128;
#pragma unroll
        for (int et = 0; et < 4; ++et)
#pragma unroll
          for (int gp = 0; gp < 4; gp += 2) {
            u32x2 wq[2];
#pragma unroll
            for (int k2 = 0; k2 < 2; ++k2) {
              const int gq = gp + k2;
              const int e0 = et * 32 + 8 * gq + 4 * h;
              const f32x4 hg = *(const f32x4*)(P.in[26] + e0);
              const u32x2 sv = *(const u32x2*)(sgr + e0);
              wq[k2].x = pk_bf16(oacc[et][4 * gq] * rs * hg[0] * bf_lo(sv.x), oacc[et][4 * gq + 1] * rs * hg[1] * bf_hi(sv.x));
              wq[k2].y = pk_bf16(oacc[et][4 * gq + 2] * rs * hg[2] * bf_lo(sv.y), oacc[et][4 * gq + 3] * rs * hg[3] * bf_hi(sv.y));
            }
            const u32x2 snd = h ? wq[0] : wq[1];
            u32x2 rcv; rcv.x = (unsigned)__shfl_xor((int)snd.x, 32); rcv.y = (unsigned)__shfl_xor((int)snd.y, 32);
            const u32x4 o4 = h ? (u32x4){rcv.x, rcv.y, wq[1].x, wq[1].y} : (u32x4){wq[0].x, wq[0].y, rcv.x, rcv.y};
            *(u32x4*)(og + ktidx(token, head * 128 + et * 32 + 8 * (gp + h), MT)) = o4;
          }
      }
    }
    __syncthreads();
  }
}

DI void grid_bar(unsigned* base, const unsigned k, const unsigned xcc, const unsigned nx, const unsigned nact) {
  asm volatile("s_waitcnt vmcnt(0)" ::: "memory");
  __syncthreads();
  if (threadIdx.x == 0) {
    const unsigned old = __hip_atomic_fetch_add(base + 24 + xcc, 1u, __ATOMIC_RELAXED, __HIP_MEMORY_SCOPE_AGENT);
    if (old + 1 == k * nx) {
      __builtin_amdgcn_fence(__ATOMIC_RELEASE, "agent");
      asm volatile("s_waitcnt vmcnt(0)" ::: "memory");
      __hip_atomic_fetch_add(base + 16, 1u, __ATOMIC_RELAXED, __HIP_MEMORY_SCOPE_AGENT);
    }
    unsigned spins = 0;
    while (__hip_atomic_load(base + 16, __ATOMIC_RELAXED, __HIP_MEMORY_SCOPE_AGENT) < k * nact && spins < (1u << 24)) { __builtin_amdgcn_s_sleep(1); ++spins; }
    __builtin_amdgcn_fence(__ATOMIC_ACQUIRE, "agent");
    asm volatile("s_waitcnt vmcnt(0)" ::: "memory");
  }
  __syncthreads();
}

__global__ void __launch_bounds__(256, 2) hawk_yoco_mega(Params P) {
  extern __shared__ __attribute__((aligned(16))) unsigned char lds[];
  cg::grid_group grid = cg::this_grid();
  unsigned char* ws = P.ws;
  int my_xcc, my_lr;
  {
    volatile int* shr = (volatile int*)(lds + LDS_BYTES - 16);
    if (threadIdx.x == 0) {
      const unsigned xcc = __builtin_amdgcn_s_getreg(0xF814) & 7u;
      shr[0] = (int)xcc; shr[1] = (int)atomicAdd((unsigned*)(ws + W_XCNT) + xcc, 1u);
    }
    __syncthreads();
    my_xcc = shr[0]; my_lr = shr[1];
    __syncthreads();
  }
  int gv = 0;
#define vx ((gv & 511) >> 6)
#define vl (gv & 63)
#define nvx ((int)(gridDim.x >> 6))
#ifndef PROBE_PH
#define PROBE_PH -1
#endif
#define PH_BEGIN(n) if (P.ph_lo <= (n) && (n) < P.ph_hi) { _Pragma("unroll 1") for (int rep = 0; rep < ((n) == PROBE_PH ? 2 : 1); ++rep) { if (rep) grid.sync();
#define PH_END(n) } if ((n) + 1 < P.ph_hi) { if ((n) == 0) grid.sync(); else grid_bar((unsigned*)(ws + W_XCNT), (unsigned)(n), (unsigned)(gv >> 9) & 7u, (unsigned)(gv >> 12) & 1023u, (unsigned)(gv >> 22) & 15u); } }
  PH_BEGIN(0)
    prep_phase(P, lds);
  PH_END(0)
  {
    int pre = 0, mynx = 0, nact = 0;
    for (int x = 0; x < 8; ++x) { const int c = (int)__hip_atomic_load((unsigned*)(ws + W_XCNT) + x, __ATOMIC_RELAXED, __HIP_MEMORY_SCOPE_AGENT); if (x < my_xcc) pre += c; if (x == my_xcc) mynx = c; if (c > 0) ++nact; }
    gv = (pre + my_lr) | (my_xcc << 9) | (mynx << 12) | (nact << 22);
  }
  PH_BEGIN(1)
    Epi1 e{(const float*)(ws + W_RSTD0), (bf16_t*)(ws + W_S1), (bf16_t*)(ws + W_S2), lds};
    gemm_phase<1024, 22, true>((const bf16_t*)(ws + W_S0), (const bf16_t*)(ws + W_W1), lds, e, vx, vl, nvx);
  PH_END(1)
  PH_BEGIN(2)
    rec_phase(P, lds);
  PH_END(2)
  PH_BEGIN(3)
    Epi2 e{P.in[0], P.in[1], P.out + O_YP, P.out + O_YS, (bf16_t*)(ws + W_S0), (float*)(ws + W_SUMSQ), lds};
    gemm_phase<1408, 8, true>((const bf16_t*)(ws + W_S3), (const bf16_t*)(ws + W_W2), lds, e, vx, vl, nvx);
  PH_END(3)
  PH_BEGIN(4)
    Epi3 e{(const float*)(ws + W_SUMSQ), P.in[18], P.in[21], (const float2*)(ws + W_ROPE),
           P.out + O_KP, P.out + O_VP, P.out + O_KS, P.out + O_VS,
           (bf16_t*)(ws + W_S1), (bf16_t*)(ws + W_S2), (bf16_t*)(ws + W_KBS), (bf16_t*)(ws + W_VTS), (bf16_t*)(ws + W_S3), (bf16_t*)(ws + W_S4)};
    gemm_phase<1024, 32, false>((const bf16_t*)(ws + W_S0), (const bf16_t*)(ws + W_W3), lds, e, vx, vl, nvx);
  PH_END(4)
  PH_BEGIN(5)
    attn_phase(P, lds, rep, vx);
  PH_END(5)
  PH_BEGIN(6)
    Epi4 e{P.out + O_YP, P.out + O_YS, lds};
    gemm_phase<1024, 8, true>((const bf16_t*)(ws + W_S0), (const bf16_t*)(ws + W_W4), lds, e, vx, vl, nvx);
  PH_END(6)
}

#undef vx
#undef vl
#undef nvx
extern "C" void kernel_launch(void* const* d_in, const int* in_sizes, int n_in, void* d_out, int out_size, void* d_ws, size_t ws_size,
                              hipStream_t stream) {
  static int grid_blocks = 0;
  if (grid_blocks == 0) {
    if (n_in != 28 || ws_size < W_END) { fprintf(stderr, "kernel_launch: unexpected n_in %d / ws_size %zu (need %zu)\n", n_in, ws_size, (size_t)W_END); grid_blocks = -1; return; }
    int dev = 0, cus = 0, per_cu = 0;
    hipGetDevice(&dev);
    hipDeviceGetAttribute(&cus, hipDeviceAttributeMultiprocessorCount, dev);
    hipFuncSetAttribute((const void*)hawk_yoco_mega, hipFuncAttributeMaxDynamicSharedMemorySize, LDS_BYTES);
    hipOccupancyMaxActiveBlocksPerMultiprocessor(&per_cu, (const void*)hawk_yoco_mega, 256, LDS_BYTES);
    if (per_cu < 1) per_cu = 1;
    if (per_cu > 2) per_cu = 2;
    per_cu = 2;
    grid_blocks = cus * per_cu;
    fprintf(stderr, "kernel_launch: cus %d per_cu %d grid %d\n", cus, per_cu, grid_blocks);
  }
  if (grid_blocks < 0) return;
  Params p{};
  for (int i = 0; i < 28; ++i) p.in[i] = (const float*)d_in[i];
  p.out = (float*)d_out; p.ws = (unsigned char*)d_ws;
  p.ph_lo = 0; p.ph_hi = 7;
  (void)hipMemsetAsync((unsigned char*)d_ws + W_XCNT, 0, 256, stream);
  void* args[] = {&p};
  hipError_t e = hipLaunchCooperativeKernel((const void*)hawk_yoco_mega, dim3(grid_blocks), dim3(256), args, LDS_BYTES, stream);
  if (e != hipSuccess) fprintf(stderr, "cooperative launch failed: %s (grid %d)\n", hipGetErrorString(e), grid_blocks);
}
```
